# Optimizing an MI355X kernel written in HIP

```python
import jax, jax.numpy as jnp
from jax import lax
import numpy as np

D_MODEL = 2048
BATCH = 2
SEQ = 8192
DEPTH = 1

GRID_W = 64
HEAD_DIM = 128
N_HEADS = D_MODEL // HEAD_DIM
N_HEADS_NA = N_HEADS // 4
N_HEADS_DIL = N_HEADS - N_HEADS_NA
W_NA = N_HEADS_NA * HEAD_DIM
W_DIL = N_HEADS_DIL * HEAD_DIM
NA_ROWS = 8
NA_COLS = 16
NA_QCOLS = 16
NA_KCOLS = NA_QCOLS + NA_COLS
DIL_PAIRS = ((128, 1), (512, 4), (2048, 16))
D_FF = 5632
PLE_DIM = 256
ROPE_THETA = 10000.0
EPS = 1e-6
NEG = -1e30

kernel_name = "hymba_style_na_dilated_macaron_encoder"


def _rmsnorm(x, g):
    xf = x.astype(jnp.float32)
    y = xf * lax.rsqrt(jnp.mean(xf * xf, axis=-1, keepdims=True) + EPS) * g.astype(jnp.float32)
    return y.astype(x.dtype)


def _swiglu(u, w_gate, w_up, w_down):
    return (jax.nn.silu(u @ w_gate) * (u @ w_up)) @ w_down


def _rope(t):
    S, hd = t.shape[2], t.shape[3]
    inv = jnp.float32(ROPE_THETA) ** (-jnp.arange(0, hd, 2, dtype=jnp.float32) / hd)
    ang = jnp.arange(S, dtype=jnp.float32)[:, None] * inv[None, :]
    cos, sin = jnp.cos(ang), jnp.sin(ang)
    tf = t.astype(jnp.float32)
    t1, t2 = tf[..., : hd // 2], tf[..., hd // 2:]
    return jnp.concatenate([t1 * cos - t2 * sin, t2 * cos + t1 * sin], axis=-1).astype(t.dtype)


def _na_indices(rows):
    kr = min(NA_ROWS, rows)
    n_cb = GRID_W // NA_QCOLS
    r = np.arange(rows)
    rs = np.clip(r - kr // 2, 0, rows - kr)
    krow = rs[:, None] + np.arange(kr)[None, :]
    cb0 = np.arange(n_cb) * NA_QCOLS
    kcs = np.clip(cb0 - NA_COLS // 2, 0, GRID_W - NA_KCOLS)
    kcol = kcs[:, None] + np.arange(NA_KCOLS)[None, :]
    qcol = cb0[:, None] + np.arange(NA_QCOLS)[None, :]
    qs = np.clip(qcol - NA_COLS // 2, 0, GRID_W - NA_COLS)
    tok = krow[:, None, :, None] * GRID_W + kcol[None, :, None, :]
    col_ok = (kcol[:, None, :] >= qs[:, :, None]) & (kcol[:, None, :] < qs[:, :, None] + NA_COLS)
    col_ok = np.broadcast_to(col_ok[:, :, None, :], (n_cb, NA_QCOLS, kr, NA_KCOLS)).reshape(n_cb, NA_QCOLS, kr * NA_KCOLS)
    dr = krow - r[:, None] + NA_ROWS - 1
    dc = np.clip(kcol[:, None, :] - qcol[:, :, None] + NA_COLS - 1, 0, 2 * NA_COLS - 2)
    return kr, n_cb, tok, col_ok, dr, dc


def _neighborhood_attention(q, k, v, rpb):
    B, H, S, hd = q.shape
    rows = S // GRID_W
    kr, n_cb, tok, col_ok, dr, dc = _na_indices(rows)
    nk = kr * NA_KCOLS
    qb = q.reshape(B, H, rows, n_cb, NA_QCOLS, hd)
    flat = tok.reshape(-1)
    kb = jnp.take(k, flat, axis=2).reshape(B, H, rows, n_cb, nk, hd)
    vb = jnp.take(v, flat, axis=2).reshape(B, H, rows, n_cb, nk, hd)
    bias = rpb[:, dr[:, None, None, :, None], dc[None, :, :, None, :]]
    bias = bias.reshape(H, rows, n_cb, NA_QCOLS, nk).astype(jnp.float32)
    s = jnp.einsum('bhrcqd,bhrckd->bhrcqk', qb, kb).astype(jnp.float32) * (hd ** -0.5) + bias[None]
    s = jnp.where(col_ok, s, NEG)
    pr = jax.nn.softmax(s, axis=-1)
    o = jnp.einsum('bhrcqk,bhrckd->bhrcqd', pr.astype(v.dtype), vb)
    return o.reshape(B, H, S, hd)


def _dilated_branch(q, k, v, window, dil):
    B, H, S, hd = q.shape
    half = window // (2 * dil)
    blk = half
    L = S // dil
    nb = -(-L // blk)
    Lp = nb * blk

    def fold(t):
        return t.reshape(B, H, L, dil, hd).transpose(0, 1, 3, 2, 4)

    def kwin(t):
        tp = jnp.pad(t, ((0, 0), (0, 0), (0, 0), (blk, Lp - L + blk), (0, 0))).reshape(B, H, dil, nb + 2, blk, hd)
        return jnp.concatenate([tp[:, :, :, :-2], tp[:, :, :, 1:-1], tp[:, :, :, 2:]], axis=4)

    qb = jnp.pad(fold(q), ((0, 0), (0, 0), (0, 0), (0, Lp - L), (0, 0))).reshape(B, H, dil, nb, blk, hd)
    kb, vb = kwin(fold(k)), kwin(fold(v))
    m_q = np.arange(nb)[:, None] * blk + np.arange(blk)[None, :]
    m_k = np.arange(nb)[:, None] * blk - blk + np.arange(3 * blk)[None, :]
    mk = m_k[:, None, :]
    valid = (np.abs(mk - m_q[:, :, None]) <= half) & (mk >= 0) & (mk < L)
    s = jnp.einsum('bhrnqd,bhrnkd->bhrnqk', qb, kb).astype(jnp.float32) * (hd ** -0.5)
    s = jnp.where(valid, s, NEG)
    mx = jnp.max(s, axis=-1, keepdims=True)
    e = jnp.exp(s - mx)
    den = jnp.sum(e, axis=-1, keepdims=True)
    o = jnp.einsum('bhrnqk,bhrnkd->bhrnqd', e, vb.astype(jnp.float32)) / den
    lse = (mx + jnp.log(den))[..., 0]
    o = o.reshape(B, H, dil, Lp, hd)[:, :, :, :L].transpose(0, 1, 3, 2, 4).reshape(B, H, S, hd)
    lse = lse.reshape(B, H, dil, Lp)[:, :, :, :L].transpose(0, 1, 3, 2).reshape(B, H, S)
    return o, lse


def _dilated_mixture(q, k, v):
    res = [_dilated_branch(q, k, v, w, d) for (w, d) in DIL_PAIRS]
    o_all = jnp.stack([r[0] for r in res], axis=0)
    wts = jax.nn.softmax(jnp.stack([r[1] for r in res], axis=0), axis=0)
    return jnp.einsum('pbhs,pbhsd->bhsd', wts, o_all).astype(q.dtype)


def _mixer(u, w_qkv, na_rpb, out_g, w_o):
    B, S, _ = u.shape
    qkv = u @ w_qkv
    cuts = np.cumsum([W_NA, W_NA, W_NA, W_DIL, W_DIL])
    qa, ka, va, qd, kd, vd = jnp.split(qkv, cuts, axis=-1)

    def heads(t):
        return t.reshape(B, S, -1, HEAD_DIM).transpose(0, 2, 1, 3)

    o_na = _neighborhood_attention(heads(qa), heads(ka), heads(va), na_rpb)
    o_dil = _dilated_mixture(_rope(heads(qd)), _rope(heads(kd)), heads(vd))
    o = jnp.concatenate([o_na, o_dil], axis=1).astype(jnp.float32)
    o = o * lax.rsqrt(jnp.mean(o * o, axis=-1, keepdims=True) + EPS)
    o = o.transpose(0, 2, 1, 3).reshape(B, S, D_MODEL) * out_g.astype(jnp.float32)
    return o.astype(u.dtype) @ w_o


def setup_inputs(seed: int = 0) -> dict:
    key = jax.random.key(seed)
    ks = jax.random.split(key, 24)
    D = D_MODEL
    f32 = jnp.float32

    def nrm(k, shape, scale):
        return jax.random.normal(k, shape, f32) * scale

    def gain(k):
        return 1.0 + 0.05 * jax.random.normal(k, (DEPTH, D), f32)

    return {
        "x": nrm(ks[0], (BATCH, SEQ, D), 1.0),
        "p": nrm(ks[1], (DEPTH, BATCH, SEQ, PLE_DIM), 1.0),
        "ffn1_pre_g": gain(ks[2]),
        "ffn1_w_gate": nrm(ks[3], (DEPTH, D, D_FF), D ** -0.5),
        "ffn1_w_up": nrm(ks[4], (DEPTH, D, D_FF), D ** -0.5),
        "ffn1_w_down": nrm(ks[5], (DEPTH, D_FF, D), D_FF ** -0.5),
        "ffn1_post_g": gain(ks[6]),
        "mix_pre_g": gain(ks[7]),
        "w_qkv": nrm(ks[8], (DEPTH, D, 3 * D), D ** -0.5),
        "na_rpb": nrm(ks[9], (DEPTH, N_HEADS_NA, 2 * NA_ROWS - 1, 2 * NA_COLS - 1), 0.1),
        "out_g": gain(ks[10]),
        "w_o": nrm(ks[11], (DEPTH, D, D), D ** -0.5),
        "mix_post_g": gain(ks[12]),
        "ffn2_pre_g": gain(ks[13]),
        "ffn2_w_gate": nrm(ks[14], (DEPTH, D, D_FF), D ** -0.5),
        "ffn2_w_up": nrm(ks[15], (DEPTH, D, D_FF), D ** -0.5),
        "ffn2_w_down": nrm(ks[16], (DEPTH, D_FF, D), D_FF ** -0.5),
        "ffn2_post_g": gain(ks[17]),
        "ple_pre_g": gain(ks[18]),
        "w_ple_gate": nrm(ks[19], (DEPTH, D, D), D ** -0.5),
        "w_ple_proj": nrm(ks[20], (DEPTH, PLE_DIM, D), PLE_DIM ** -0.5),
        "ple_post_g": gain(ks[21]),
    }


def reference(x, p, ffn1_pre_g, ffn1_w_gate, ffn1_w_up, ffn1_w_down, ffn1_post_g,
              mix_pre_g, w_qkv, na_rpb, out_g, w_o, mix_post_g,
              ffn2_pre_g, ffn2_w_gate, ffn2_w_up, ffn2_w_down, ffn2_post_g,
              ple_pre_g, w_ple_gate, w_ple_proj, ple_post_g):
    h = x
    for i in range(DEPTH):
        f = _swiglu(_rmsnorm(h, ffn1_pre_g[i]), ffn1_w_gate[i], ffn1_w_up[i], ffn1_w_down[i])
        h = h + 0.5 * _rmsnorm(f, ffn1_post_g[i])
        m = _mixer(_rmsnorm(h, mix_pre_g[i]), w_qkv[i], na_rpb[i], out_g[i], w_o[i])
        h = h + _rmsnorm(m, mix_post_g[i])
        f = _swiglu(_rmsnorm(h, ffn2_pre_g[i]), ffn2_w_gate[i], ffn2_w_up[i], ffn2_w_down[i])
        h = h + 0.5 * _rmsnorm(f, ffn2_post_g[i])
        g = jax.nn.sigmoid(_rmsnorm(h, ple_pre_g[i]) @ w_ple_gate[i])
        h = h + _rmsnorm(g * (p[i] @ w_ple_proj[i]), ple_post_g[i])
    return h
```

```cpp
#include <hip/hip_runtime.h>
#include <hip/hip_cooperative_groups.h>
#include <cstdio>
namespace cg = cooperative_groups;

#define LAS __attribute__((address_space(3)))
typedef unsigned short bf16_t;
typedef short bf16x8 __attribute__((ext_vector_type(8)));
typedef short s16x4 __attribute__((ext_vector_type(4)));
typedef float f32x4 __attribute__((ext_vector_type(4)));
typedef float f32x16 __attribute__((ext_vector_type(16)));
typedef unsigned u32x4 __attribute__((ext_vector_type(4)));
typedef unsigned u32x2 __attribute__((ext_vector_type(2)));

constexpr int MTOK = 16384, SEQ = 8192, DM = 2048, DFF = 5632, NQKV = 6144, PLE = 256;
constexpr float EPS = 1e-6f;
constexpr float LOG2E = 1.4426950408889634f, LN2 = 0.6931471805599453f;
constexpr float QSCALE = 0.088388347648318440f * 1.4426950408889634f;
constexpr float NEGBIG = -1e30f;

constexpr size_t OFF_W1A = 0;
constexpr size_t OFF_W1B = OFF_W1A + (size_t)11264 * 2048 * 2;
constexpr size_t OFF_WQKV = OFF_W1B + (size_t)2048 * 5632 * 2;
constexpr size_t OFF_WPG = OFF_WQKV;
constexpr size_t OFF_WPP = OFF_WQKV + (size_t)2048 * 2048 * 2;
constexpr size_t OFF_WO = OFF_WQKV + (size_t)6144 * 2048 * 2;
constexpr size_t OFF_ROPE = OFF_WO + (size_t)2048 * 2048 * 2;
constexpr size_t OFF_PBF = OFF_ROPE + (size_t)8192 * 64 * 4 * 2;
constexpr size_t OFF_LSE = OFF_PBF + (size_t)MTOK * 256 * 2;
constexpr size_t OFF_RS = OFF_LSE + (size_t)3 * MTOK * 12 * 4;
constexpr size_t OFF_HB = OFF_RS + (size_t)MTOK * 4;
constexpr size_t OFF_F = OFF_HB + (size_t)MTOK * 2048 * 2;
constexpr size_t OFF_PP = OFF_F + (size_t)MTOK * 2048 * 2;
constexpr size_t OFF_X = OFF_PP + (size_t)MTOK * 2048 * 2;
constexpr size_t OBR_BYTES = (size_t)MTOK * 1536 * 2;
constexpr size_t OFF_BAR = OFF_X + (size_t)MTOK * 6144 * 2;
constexpr size_t WS_END = OFF_BAR + 16384;
static_assert(OFF_F + 2 * OBR_BYTES <= OFF_X && OBR_BYTES + (size_t)MTOK * 512 * 2 <= (size_t)MTOK * DM * 4, "attention scratch must fit in F+PP and d_out");
__device__ __forceinline__ bf16_t* obr_base(unsigned char* ws_, unsigned char* outb, int p) { return (bf16_t*)(p < 2 ? ws_ + OFF_F + (size_t)p * OBR_BYTES : outb); }
__device__ __forceinline__ bf16_t* ona_base(unsigned char* outb) { return (bf16_t*)(outb + OBR_BYTES); }
static_assert(WS_END <= (size_t)512 * 1024 * 1024, "workspace");

struct Params { const float* in[22]; float* out; unsigned char* ws; };

__device__ __forceinline__ unsigned cvt_pk_bf16(float lo, float hi) { unsigned r; asm volatile("v_cvt_pk_bf16_f32 %0, %1, %2" : "=v"(r) : "v"(lo), "v"(hi)); return r; }
__device__ __forceinline__ float bf_lo(unsigned w) { return __uint_as_float(w << 16); }
__device__ __forceinline__ float bf_hi(unsigned w) { return __uint_as_float(w & 0xffff0000u); }
__device__ __forceinline__ float wave_sum(float v) {
#pragma unroll
    for (int o = 1; o < 64; o <<= 1) v += __shfl_xor(v, o);
    return v;
}
__device__ __forceinline__ int fresh_tid() { int t = threadIdx.x; asm volatile("" : "+v"(t)); return t; }
__device__ __forceinline__ float fast_rcp(float x) { return __builtin_amdgcn_rcpf(x); }
__device__ __forceinline__ float fast_exp2(float x) { return __builtin_amdgcn_exp2f(x); }

namespace pg8 {
constexpr int BM = 256, BK = 64, HALF = 128, HTB = HALF * BK * 2, STAGE_BYTES = 8 * HTB, NXCD = 8, WGM = 8;
__device__ __forceinline__ int lds_byte(int r, int c) { const int st = (r >> 4) * 2 + (c >> 5), rr = r & 15, cc = c & 31, ob = rr * 64 + cc * 2; return st * 1024 + (ob ^ (((ob >> 9) & 1) << 5)); }
__device__ __forceinline__ void stage_rc(int b, int& R, int& C) { const int st = b / 1024, sb = b % 1024, swz = sb ^ (((sb >> 9) & 1) << 5); R = (st >> 1) * 16 + swz / 64; C = (st & 1) * 32 + (swz % 64) / 2; }
__device__ __forceinline__ int perm32(int rho) { const int n = rho >> 4, i = rho & 15; return 8 * (i >> 2) + 4 * n + (i & 3); }
struct Unit { int pm, pn; };
struct Gemm { const bf16_t* A; const bf16_t* Bt; int M, N, K; };
struct StaticOrder {
    int nM, nN, nwg, G, c;
    __device__ void init(int M, int N, int G_, int c_) { nM = M / BM; nN = N / BM; nwg = nM * nN; G = G_; c = c_; }
    __device__ bool next(int i, Unit& u) const {
        const long L = (long)i * G + c; if (L >= nwg) return false;
        int wgid = (int)L; { const int q = nwg / NXCD, r = nwg % NXCD, xcd = wgid % NXCD, off = wgid / NXCD; wgid = (xcd < r ? xcd * (q + 1) : r * (q + 1) + (xcd - r) * q) + off; }
        const int nig = WGM * nN, gid = wgid / nig, fm = gid * WGM, gsz = (nM - fm) < WGM ? (nM - fm) : WGM;
        u.pm = fm + ((wgid % nig) % gsz); u.pn = (wgid % nig) / gsz; return true;
    }
};

template <class Epi>
__device__ __forceinline__ void gemm_phase(LAS unsigned char* lds, const Gemm g, const StaticOrder& S, const Epi& E) {
    const int tid = fresh_tid(), wid = __builtin_amdgcn_readfirstlane(tid >> 6), lane = tid & 63, wr = wid >> 2, wc = wid & 3, fr = lane & 15, fq = lane >> 4;
    const int K = g.K, nt = K / BK;
    unsigned voffA[2], voffB[2];
#pragma unroll
    for (int i = 0; i < 2; ++i) { int R, C; stage_rc(tid * 16 + i * 8192, R, C); const int Rb = (R & ~31) + perm32(R & 31);
        voffA[i] = (unsigned)(R * K + C) * 2u; voffB[i] = (unsigned)(Rb * K + C) * 2u; }
    const size_t kstep = (size_t)(BK * 2);
    const size_t hstep = (size_t)HALF * K * 2;
    const size_t tstep = 2 * hstep;
    const unsigned ldsw = (unsigned)wid * 1024u;
    const int aoff = lds_byte(wr * 64 + fr, fq * 8), boff = lds_byte(wc * 32 + fr, fq * 8);
#define PG8_SA(b, h) (((b) * 2 + (h)) * HTB)
#define PG8_SB(b, h) ((4 + (b) * 2 + (h)) * HTB)
#define PG8_STAGE(bufoff, gbase, voff) do { _Pragma("unroll") for (int _i = 0; _i < 2; ++_i) \
        __builtin_amdgcn_global_load_lds((const unsigned*)((const char*)(gbase) + (voff)[_i]), (LAS unsigned*)(lds + (bufoff) + ldsw + _i * 8192), 16, 0, 0); } while (0)
#define PG8_LDA(dst, b, h) do { _Pragma("unroll") for (int m = 0; m < 4; ++m) _Pragma("unroll") for (int k = 0; k < 2; ++k) dst[m][k] = *(const LAS bf16x8*)(lds + PG8_SA(b, h) + aoff + m * 2048 + k * 1024); } while (0)
#define PG8_LDB(dst, b, h) do { _Pragma("unroll") for (int n = 0; n < 2; ++n) _Pragma("unroll") for (int k = 0; k < 2; ++k) dst[n][k] = *(const LAS bf16x8*)(lds + PG8_SB(b, h) + boff + n * 2048 + k * 1024); } while (0)
#define PG8_MMA(ai, bj, At, Bt) do { __builtin_amdgcn_s_setprio(1); _Pragma("unroll") for (int m = 0; m < 4; ++m) _Pragma("unroll") for (int n = 0; n < 2; ++n) _Pragma("unroll") for (int k = 0; k < 2; ++k) \
        acc[ai][bj][m][n] = __builtin_amdgcn_mfma_f32_16x16x32_bf16(Bt[n][k], At[m][k], acc[ai][bj][m][n], 0, 0, 0); __builtin_amdgcn_s_setprio(0); } while (0)
#define PG8_WAIT_V(n) asm volatile("s_waitcnt vmcnt(" #n ")" ::: "memory")
#define PG8_WAIT_L(n) asm volatile("s_waitcnt lgkmcnt(" #n ")" ::: "memory")
#define PG8_BAR __builtin_amdgcn_s_barrier()
#define PG8_SCHED __builtin_amdgcn_sched_barrier(0)
    Unit cur, nxt; int ui = 0;
    if (!S.next(0, cur)) return;
    f32x4 acc[2][2][4][2];
#pragma unroll
    for (int a = 0; a < 2; ++a)
#pragma unroll
        for (int b = 0; b < 2; ++b)
#pragma unroll
            for (int m = 0; m < 4; ++m)
#pragma unroll
                for (int n = 0; n < 2; ++n) acc[a][b][m][n] = (f32x4){0.f, 0.f, 0.f, 0.f};
    bf16x8 At[4][2], B0[2][2], B1[2][2];
    const char* cA = (const char*)g.A + (size_t)cur.pm * tstep; const char* cB = (const char*)g.Bt + (size_t)cur.pn * tstep;
    PG8_STAGE(PG8_SB(0, 0), cB, voffB); PG8_STAGE(PG8_SA(0, 0), cA, voffA); PG8_STAGE(PG8_SB(0, 1), cB + hstep, voffB); PG8_STAGE(PG8_SA(0, 1), cA + hstep, voffA);
    if (wr == 1) PG8_BAR;
    PG8_WAIT_V(4); PG8_BAR;
    PG8_STAGE(PG8_SB(1, 0), cB + kstep, voffB); PG8_STAGE(PG8_SA(1, 0), cA + kstep, voffA); PG8_STAGE(PG8_SB(1, 1), cB + hstep + kstep, voffB);
    PG8_WAIT_V(6); PG8_BAR;
    for (;;) {
        const bool has_next = S.next(ui + 1, nxt);
        const char* nA = has_next ? (const char*)g.A + (size_t)nxt.pm * tstep : cA; const char* nB = has_next ? (const char*)g.Bt + (size_t)nxt.pn * tstep : cB;
        for (int t = 0; t < nt; t += 2) {
            const bool last = (t == nt - 2);
            const char* a1 = cA + (size_t)(t + 1) * kstep;
            const char* a2 = last ? nA : cA + (size_t)(t + 2) * kstep; const char* b2 = last ? nB : cB + (size_t)(t + 2) * kstep;
            const char* a3 = a2 + kstep; const char* b3 = b2 + kstep;
            PG8_LDB(B0, 0, 0); PG8_SCHED; PG8_LDA(At, 0, 0); PG8_STAGE(PG8_SA(1, 1), a1 + hstep, voffA);
            PG8_WAIT_L(8); PG8_BAR; PG8_WAIT_L(0); PG8_MMA(0, 0, At, B0); PG8_BAR; PG8_SCHED;
            PG8_LDB(B1, 0, 1); PG8_STAGE(PG8_SB(0, 0), b2, voffB);
            PG8_BAR; PG8_WAIT_L(0); PG8_MMA(0, 1, At, B1); PG8_BAR;
            PG8_LDA(At, 0, 1); PG8_STAGE(PG8_SA(0, 0), a2, voffA);
            PG8_BAR; PG8_WAIT_L(0); PG8_MMA(1, 0, At, B0); PG8_BAR; PG8_SCHED;
            PG8_STAGE(PG8_SB(0, 1), b2 + hstep, voffB);
            PG8_WAIT_V(6); PG8_BAR; PG8_MMA(1, 1, At, B1); PG8_BAR;
            PG8_LDB(B0, 1, 0); PG8_SCHED; PG8_LDA(At, 1, 0); PG8_STAGE(PG8_SA(0, 1), a2 + hstep, voffA);
            PG8_WAIT_L(8); PG8_BAR; PG8_WAIT_L(0); PG8_MMA(0, 0, At, B0); PG8_BAR; PG8_SCHED;
            PG8_LDB(B1, 1, 1); PG8_STAGE(PG8_SB(1, 0), b3, voffB);
            PG8_BAR; PG8_WAIT_L(0); PG8_MMA(0, 1, At, B1); PG8_BAR;
            PG8_LDA(At, 1, 1); PG8_STAGE(PG8_SA(1, 0), a3, voffA);
            PG8_BAR; PG8_WAIT_L(0); PG8_MMA(1, 0, At, B0); PG8_BAR; PG8_SCHED;
            PG8_STAGE(PG8_SB(1, 1), b3 + hstep, voffB);
            PG8_WAIT_V(6); PG8_BAR; PG8_MMA(1, 1, At, B1); PG8_BAR;
        }
        E(acc, cur, wr, wc, fr, fq);
        if (!has_next) break;
#pragma unroll
        for (int a = 0; a < 2; ++a)
#pragma unroll
            for (int b = 0; b < 2; ++b)
#pragma unroll
                for (int m = 0; m < 4; ++m)
#pragma unroll
                    for (int n = 0; n < 2; ++n) acc[a][b][m][n] = (f32x4){0.f, 0.f, 0.f, 0.f};
        cur = nxt; cA = nA; cB = nB; ++ui;
    }
    PG8_WAIT_V(0);
    if (wr == 0) PG8_BAR;
    PG8_BAR;
#undef PG8_SA
#undef PG8_SB
#undef PG8_STAGE
#undef PG8_LDA
#undef PG8_LDB
#undef PG8_MMA
#undef PG8_WAIT_V
#undef PG8_WAIT_L
#undef PG8_BAR
#undef PG8_SCHED
}

__device__ __forceinline__ u32x4 pack8(f32x4 v0, f32x4 v1) { u32x4 w; w.x = cvt_pk_bf16(v0[0], v0[1]); w.y = cvt_pk_bf16(v0[2], v0[3]); w.z = cvt_pk_bf16(v1[0], v1[1]); w.w = cvt_pk_bf16(v1[2], v1[3]); return w; }

struct EpiPlain {
    bf16_t* O; int ldc;
    __device__ __forceinline__ void operator()(const f32x4 (&acc)[2][2][4][2], const Unit& u, int wr, int wc, int fr, int fq) const {
        const int row0 = u.pm * BM + wr * 64 + fr, col0 = u.pn * BM + wc * 32 + 8 * fq;
#pragma unroll
        for (int ai = 0; ai < 2; ++ai)
#pragma unroll
            for (int m = 0; m < 4; ++m) { bf16_t* rowp = O + (size_t)(row0 + ai * HALF + m * 16) * ldc + col0;
#pragma unroll
                for (int bj = 0; bj < 2; ++bj) *(u32x4*)(rowp + bj * HALF) = pack8(acc[ai][bj][m][0], acc[ai][bj][m][1]); }
    }
};
struct EpiSwiglu {
    bf16_t* O; const float* rs;
    __device__ __forceinline__ void operator()(const f32x4 (&acc)[2][2][4][2], const Unit& u, int wr, int wc, int fr, int fq) const {
        const int row0 = u.pm * BM + wr * 64 + fr, col0 = u.pn * HALF + wc * 32 + 8 * fq;
#pragma unroll
        for (int ai = 0; ai < 2; ++ai)
#pragma unroll
            for (int m = 0; m < 4; ++m) { bf16_t* rowp = O + (size_t)(row0 + ai * HALF + m * 16) * DFF + col0;
                const float r = rs[row0 + ai * HALF + m * 16], r2 = r * r;
                f32x4 h0, h1;
#pragma unroll
                for (int j = 0; j < 4; ++j) {
                    const float g0 = acc[ai][0][m][0][j], g1 = acc[ai][0][m][1][j];
                    h0[j] = g0 * r2 * fast_rcp(1.0f + fast_exp2(g0 * (-LOG2E * r))) * acc[ai][1][m][0][j];
                    h1[j] = g1 * r2 * fast_rcp(1.0f + fast_exp2(g1 * (-LOG2E * r))) * acc[ai][1][m][1][j]; }
                *(u32x4*)rowp = pack8(h0, h1); }
    }
};
struct EpiQkv {
    bf16_t* O; const float* rc; const float* rs; const float* rowsc;
    __device__ __forceinline__ void operator()(const f32x4 (&acc)[2][2][4][2], const Unit& u, int wr, int wc, int fr, int fq) const {
        const int row0 = u.pm * BM + wr * 64 + fr;
        if (u.pn >= 6 && u.pn < 18) {
            const int d0 = 32 * (wc & 1) + 8 * fq, col1 = u.pn * BM + HALF * (wc >> 1) + d0;
            const float sc = (u.pn < 12) ? QSCALE : 1.0f;
#pragma unroll
            for (int ai = 0; ai < 2; ++ai)
#pragma unroll
                for (int m = 0; m < 4; ++m) { const int row = row0 + ai * HALF + m * 16; const int pos = row & (SEQ - 1); const float scr_ = sc * rowsc[row];
                    const f32x4 c0 = *(const f32x4*)(rc + pos * 64 + d0), c1 = *(const f32x4*)(rc + pos * 64 + d0 + 4);
                    const f32x4 s0 = *(const f32x4*)(rs + pos * 64 + d0), s1 = *(const f32x4*)(rs + pos * 64 + d0 + 4);
                    const f32x4 a0 = acc[ai][0][m][0], a1 = acc[ai][0][m][1], b0 = acc[ai][1][m][0], b1 = acc[ai][1][m][1];
                    const f32x4 o10 = (a0 * c0 - b0 * s0) * scr_, o11 = (a1 * c1 - b1 * s1) * scr_;
                    const f32x4 o20 = (b0 * c0 + a0 * s0) * scr_, o21 = (b1 * c1 + a1 * s1) * scr_;
                    bf16_t* rowp = O + (size_t)row * NQKV + col1;
                    *(u32x4*)rowp = pack8(o10, o11); *(u32x4*)(rowp + 64) = pack8(o20, o21); }
        } else {
            const int col0 = u.pn * BM + wc * 32 + 8 * fq; const float sc = (u.pn < 2) ? QSCALE : 1.0f;
#pragma unroll
            for (int ai = 0; ai < 2; ++ai)
#pragma unroll
                for (int m = 0; m < 4; ++m) { bf16_t* rowp = O + (size_t)(row0 + ai * HALF + m * 16) * NQKV + col0; const float scr_ = sc * rowsc[row0 + ai * HALF + m * 16];
#pragma unroll
                    for (int bj = 0; bj < 2; ++bj) *(u32x4*)(rowp + bj * HALF) = pack8(acc[ai][bj][m][0] * scr_, acc[ai][bj][m][1] * scr_); }
        }
    }
};
struct EpiPle {
    bf16_t* O; const bf16_t* PP; const float* rs;
    __device__ __forceinline__ void operator()(const f32x4 (&acc)[2][2][4][2], const Unit& u, int wr, int wc, int fr, int fq) const {
        const int row0 = u.pm * BM + wr * 64 + fr, col0 = u.pn * BM + wc * 32 + 8 * fq;
#pragma unroll
        for (int ai = 0; ai < 2; ++ai)
#pragma unroll
            for (int m = 0; m < 4; ++m) { const size_t ro = (size_t)(row0 + ai * HALF + m * 16) * DM + col0; const float nr = -LOG2E * rs[row0 + ai * HALF + m * 16];
#pragma unroll
                for (int bj = 0; bj < 2; ++bj) {
                    const u32x4 pw = *(const u32x4*)(PP + ro + bj * HALF);
                    const float pv[8] = {bf_lo(pw.x), bf_hi(pw.x), bf_lo(pw.y), bf_hi(pw.y), bf_lo(pw.z), bf_hi(pw.z), bf_lo(pw.w), bf_hi(pw.w)};
                    f32x4 t0, t1;
#pragma unroll
                    for (int j = 0; j < 4; ++j) {
                        t0[j] = fast_rcp(1.0f + fast_exp2(acc[ai][bj][m][0][j] * nr)) * pv[j];
                        t1[j] = fast_rcp(1.0f + fast_exp2(acc[ai][bj][m][1][j] * nr)) * pv[4 + j]; }
                    *(u32x4*)(O + ro + bj * HALF) = pack8(t0, t1); } }
    }
};
}

struct CvtDesc { const float* W0; const float* W1; bf16_t* Bt; int K, Nsrc, nslots, mode; const float* gk; };
struct CvtPos { int k0, s0, c0; const float* W; };
__device__ __forceinline__ CvtPos cvt_pos(const CvtDesc& d, int item) {
    const int nblk = d.nslots >> 5, kb = item / nblk, nb = item - kb * nblk; CvtPos p; p.k0 = 64 * kb; p.s0 = 32 * nb; p.W = d.W0; p.c0 = p.s0;
    if (d.mode == 1) { const int tile = p.s0 >> 8, bj = (p.s0 >> 7) & 1, q = p.s0 & 127; p.W = bj ? d.W1 : d.W0; p.c0 = tile * 128 + q; }
    else if (d.mode == 2) { const int pn = p.s0 >> 8; if (pn >= 6 && pn < 18) { const int bj = (p.s0 >> 7) & 1, q = p.s0 & 127; p.c0 = pn * 256 + 128 * (q >> 6) + 64 * bj + (q & 63); } }
    return p;
}
__device__ __forceinline__ void cvt_load(const CvtDesc& d, const CvtPos& p, f32x4 (&v)[8], int lane) {
    const int rr8 = lane >> 3, c4 = (lane & 7) * 4;
    const float* src = p.W + (size_t)(p.k0 + rr8) * d.Nsrc + p.c0 + c4;
#pragma unroll
    for (int i = 0; i < 8; ++i) v[i] = __builtin_nontemporal_load((const f32x4*)(src + (size_t)(8 * i) * d.Nsrc));
}
__device__ __forceinline__ void cvt_store(const CvtDesc& d, const CvtPos& p, f32x4 (&v)[8], LAS float* scr, int lane) {
    const int rr8 = lane >> 3, c4 = (lane & 7) * 4, k0 = p.k0, s0 = p.s0;
    if (d.gk) {
#pragma unroll
        for (int i = 0; i < 8; ++i) v[i] *= d.gk[k0 + 8 * i + rr8]; }
#pragma unroll
    for (int i = 0; i < 8; ++i) { LAS float* wp = scr + (8 * i + rr8) * 33 + c4; wp[0] = v[i][0]; wp[1] = v[i][1]; wp[2] = v[i][2]; wp[3] = v[i][3]; }
    asm volatile("s_waitcnt lgkmcnt(0)" ::: "memory");
    const int c = lane & 7;
#pragma unroll
    for (int j = 0; j < 4; ++j) { const int n = (lane >> 3) + 8 * j; const LAS float* s = scr + (8 * c) * 33 + n;
        u32x4 o; o.x = cvt_pk_bf16(s[0 * 33], s[1 * 33]); o.y = cvt_pk_bf16(s[2 * 33], s[3 * 33]); o.z = cvt_pk_bf16(s[4 * 33], s[5 * 33]); o.w = cvt_pk_bf16(s[6 * 33], s[7 * 33]);
        *(u32x4*)(d.Bt + (size_t)(s0 + n) * d.K + k0 + 8 * c) = o; }
    asm volatile("s_waitcnt lgkmcnt(0)" ::: "memory");
}
__device__ __forceinline__ void cvt_run(const CvtDesc& d, LAS unsigned char* lds, int wg, int nwg) {
    const int tid = fresh_tid(), wid = tid >> 6, lane = tid & 63, gw = wg * 8 + wid, NGW = nwg * 8; LAS float* scr = (LAS float*)(lds + wid * 8704);
    const int nitems = (d.K >> 6) * (d.nslots >> 5);
    int it = gw; if (it >= nitems) return;
    f32x4 vN[8]; CvtPos pN = cvt_pos(d, it); cvt_load(d, pN, vN, lane);
    for (; it < nitems; it += NGW) {
        f32x4 v[8]; const CvtPos p = pN;
#pragma unroll
        for (int i = 0; i < 8; ++i) v[i] = vN[i];
        if (it + NGW < nitems) { pN = cvt_pos(d, it + NGW); cvt_load(d, pN, vN, lane); }
        cvt_store(d, p, v, scr, lane);
    }
}

template <int MODE>
__device__ __forceinline__ void rowwise_phase(const float* xin, bf16_t* hb, const bf16_t* f, const float* gpost, float alpha, float* rsout, float* fout, int wg, int nwg) {
    const int tid = fresh_tid(), lane = tid & 63, gw = wg * 8 + (tid >> 6), NGW = nwg * 8;
    constexpr bool XIN = (MODE == 0 || MODE == 1), HASF = (MODE != 0);
    f32x4 xN[8]; u32x2 hN[8], fN[8];
#define ROW_LOAD(r_) do { \
        if (XIN) { const f32x4* xp_ = (const f32x4*)(xin + (size_t)(r_) * DM) + lane; _Pragma("unroll") for (int j = 0; j < 8; ++j) xN[j] = __builtin_nontemporal_load(xp_ + 64 * j); } \
        else { const u32x2* hp_ = (const u32x2*)(hb + (size_t)(r_) * DM) + lane; _Pragma("unroll") for (int j = 0; j < 8; ++j) hN[j] = hp_[64 * j]; } \
        if (HASF) { const u32x2* fp_ = (const u32x2*)(f + (size_t)(r_) * DM) + lane; _Pragma("unroll") for (int j = 0; j < 8; ++j) fN[j] = fp_[64 * j]; } } while (0)
    if (gw < MTOK) ROW_LOAD(gw);
    for (int row = gw; row < MTOK; row += NGW) {
        f32x4 h[8]; u32x2 fw[8];
#pragma unroll
        for (int j = 0; j < 8; ++j) { if (XIN) h[j] = xN[j]; else h[j] = (f32x4){bf_lo(hN[j].x), bf_hi(hN[j].x), bf_lo(hN[j].y), bf_hi(hN[j].y)}; if (HASF) fw[j] = fN[j]; }
        const int nrow = row + NGW;
        if (nrow < MTOK) ROW_LOAD(nrow);
        if (HASF) {
            f32x4 fv[8]; float ss = 0.f;
#pragma unroll
            for (int j = 0; j < 8; ++j) { const u32x2 w = fw[j]; fv[j] = (f32x4){bf_lo(w.x), bf_hi(w.x), bf_lo(w.y), bf_hi(w.y)};
                ss += (fv[j][0] * fv[j][0] + fv[j][1] * fv[j][1]) + (fv[j][2] * fv[j][2] + fv[j][3] * fv[j][3]); }
            ss = wave_sum(ss);
            const float rs = alpha * __frsqrt_rn(ss * (1.0f / DM) + EPS);
#pragma unroll
            for (int j = 0; j < 8; ++j) { const f32x4 g = ((const f32x4*)gpost)[lane + 64 * j]; h[j] += fv[j] * g * rs; }
        }
        if (MODE == 2) {
            f32x4* op = (f32x4*)(fout + (size_t)row * DM) + lane;
#pragma unroll
            for (int j = 0; j < 8; ++j) __builtin_nontemporal_store(h[j], op + 64 * j);
        } else {
            float s2 = 0.f;
#pragma unroll
            for (int j = 0; j < 8; ++j) s2 += (h[j][0] * h[j][0] + h[j][1] * h[j][1]) + (h[j][2] * h[j][2] + h[j][3] * h[j][3]);
            s2 = wave_sum(s2);
            if (lane == 0) rsout[row] = __frsqrt_rn(s2 * (1.0f / DM) + EPS);
            u32x2* up = (u32x2*)(hb + (size_t)row * DM) + lane;
#pragma unroll
            for (int j = 0; j < 8; ++j) { u32x2 w; w.x = cvt_pk_bf16(h[j][0], h[j][1]); w.y = cvt_pk_bf16(h[j][2], h[j][3]); up[64 * j] = w; }
        }
    }
#undef ROW_LOAD
}

#define KSWZ(row, colB) ((row) * 256 + ((colB) ^ (((row) & 7) << 4)))
#define SBAR() __builtin_amdgcn_sched_barrier(0)
__device__ __forceinline__ int crow(int r, int hi) { return (r & 3) + 8 * (r >> 2) + 4 * hi; }
__device__ __forceinline__ int v_st(int k, int c) { const int kk = (k & ~0xC) | ((k & 4) << 1) | ((k & 8) >> 1); return ((kk >> 3) * 4 + (c >> 5)) * 512 + ((kk & 7) * 32 + (c & 31)) * 2; }
__device__ __forceinline__ int v_rd_base(int lane) { return ((lane & 3) << 3) | (((lane >> 2) & 3) << 6) | (((lane >> 4) & 1) << 5) | (((lane >> 5) & 1) << 8); }
constexpr int v_rd_off(int d0, int ks, int half) { return d0 * 512 + ks * 4096 + half * 2048; }
template <int OFF> __device__ __forceinline__ s16x4 tr_read(int vb) {
    s16x4 r; asm volatile("ds_read_b64_tr_b16 %0, %1 offset:%2" : "=&v"(r) : "v"(vb), "i"(OFF) : "memory"); return r;
}
template <int D0> __device__ __forceinline__ void pv_one(f32x16& od, int vb, bf16x8 pa0, bf16x8 pa1, bf16x8 pa2, bf16x8 pa3) {
    const s16x4 l0 = tr_read<v_rd_off(D0, 0, 0)>(vb), h0 = tr_read<v_rd_off(D0, 0, 1)>(vb), l1 = tr_read<v_rd_off(D0, 1, 0)>(vb), h1 = tr_read<v_rd_off(D0, 1, 1)>(vb);
    const s16x4 l2 = tr_read<v_rd_off(D0, 2, 0)>(vb), h2 = tr_read<v_rd_off(D0, 2, 1)>(vb), l3 = tr_read<v_rd_off(D0, 3, 0)>(vb), h3 = tr_read<v_rd_off(D0, 3, 1)>(vb);
    asm volatile("s_waitcnt lgkmcnt(0)" ::: "memory"); SBAR();
#define PK(L, H) (bf16x8){L[0], L[1], L[2], L[3], H[0], H[1], H[2], H[3]}
    od = __builtin_amdgcn_mfma_f32_32x32x16_bf16(pa0, PK(l0, h0), od, 0, 0, 0);
    od = __builtin_amdgcn_mfma_f32_32x32x16_bf16(pa1, PK(l1, h1), od, 0, 0, 0);
    od = __builtin_amdgcn_mfma_f32_32x32x16_bf16(pa2, PK(l2, h2), od, 0, 0, 0);
    od = __builtin_amdgcn_mfma_f32_32x32x16_bf16(pa3, PK(l3, h3), od, 0, 0, 0);
#undef PK
}
__device__ __forceinline__ void qkt(f32x16& p0, f32x16& p1, const LAS unsigned char* Ks, const LAS unsigned char* qL, int r32, int hi) {
    p0 = f32x16{}; p1 = f32x16{};
#pragma unroll
    for (int d0 = 0; d0 < 8; ++d0) { const int cb = (d0 * 16 + hi * 8) * 2;
        const bf16x8 b0 = *(const LAS bf16x8*)(Ks + KSWZ(r32, cb));
        const bf16x8 b1 = *(const LAS bf16x8*)(Ks + KSWZ(32 + r32, cb));
        const bf16x8 q = *(const LAS bf16x8*)(qL + d0 * 1024);
        p0 = __builtin_amdgcn_mfma_f32_32x32x16_bf16(b0, q, p0, 0, 0, 0);
        p1 = __builtin_amdgcn_mfma_f32_32x32x16_bf16(b1, q, p1, 0, 0, 0); }
}
__device__ __forceinline__ void softmax_tile(f32x16& p0, f32x16& p1, float& m_reg, float& l_reg, float& alpha, bf16x8& pa0, bf16x8& pa1, bf16x8& pa2, bf16x8& pa3) {
    float pmax = p0[0];
#pragma unroll
    for (int r = 1; r < 16; ++r) pmax = fmaxf(pmax, p0[r]);
#pragma unroll
    for (int r = 0; r < 16; ++r) pmax = fmaxf(pmax, p1[r]);
    { auto rr = __builtin_amdgcn_permlane32_swap(__float_as_uint(pmax), __float_as_uint(pmax), false, false);
      pmax = fmaxf(__uint_as_float(rr[0]), __uint_as_float(rr[1])); }
    const float mn = (pmax > m_reg + 8.0f) ? pmax : m_reg;
    alpha = fast_exp2(m_reg - mn); m_reg = mn;
#pragma unroll
    for (int r = 0; r < 16; ++r) { p0[r] = fast_exp2(p0[r] - mn); p1[r] = fast_exp2(p1[r] - mn); }
    float ps = 0.f;
#pragma unroll
    for (int r = 0; r < 16; ++r) ps += p0[r];
#pragma unroll
    for (int r = 0; r < 16; ++r) ps += p1[r];
    { auto rr = __builtin_amdgcn_permlane32_swap(__float_as_uint(ps), __float_as_uint(ps), false, false);
      ps = __uint_as_float(rr[0]) + __uint_as_float(rr[1]); }
    l_reg = l_reg * alpha + ps;
#define PK4(P, BASE, OUT) do { unsigned a0 = cvt_pk_bf16(P[BASE + 0], P[BASE + 1]), a1 = cvt_pk_bf16(P[BASE + 2], P[BASE + 3]);   \
    unsigned b0 = cvt_pk_bf16(P[BASE + 4], P[BASE + 5]), b1 = cvt_pk_bf16(P[BASE + 6], P[BASE + 7]);                              \
    auto r0 = __builtin_amdgcn_permlane32_swap(a0, b0, false, false); auto r1 = __builtin_amdgcn_permlane32_swap(a1, b1, false, false); \
    u32x4 w = {r0[0], r1[0], r0[1], r1[1]}; OUT = *reinterpret_cast<bf16x8*>(&w); } while (0)
    PK4(p0, 0, pa0); PK4(p0, 8, pa1); PK4(p1, 0, pa2); PK4(p1, 8, pa3);
#undef PK4
}

constexpr int ATT_NA_ITEMS = 256, ATT_ITEMS = 256 + 2304;
struct AttItem { int isNA, b, h, dil, rr, n0, nbk, qoff, koff, voff, br, nb4, canmerge; };
__device__ __forceinline__ void att_decode(int item, AttItem& it) {
    it.nb4 = 1; it.canmerge = 0;
    if (item < ATT_NA_ITEMS) { it.isNA = 1; it.b = item >> 7; it.h = (item >> 5) & 3; it.dil = 1; it.rr = 0; it.n0 = 4 * (item & 31); it.nbk = 128; it.br = 0;
        it.qoff = it.h * 128; it.koff = 512 + it.h * 128; it.voff = 1024 + it.h * 128; }
    else { const int id = item - ATT_NA_ITEMS; it.isNA = 0; it.br = id / 768; int rem = id - it.br * 768; it.b = rem / 384; rem -= it.b * 384; it.h = rem >> 5; const int rg = rem & 31;
        const int lg = 2 * it.br, lgpr = 5 - lg, gm = (1 << lgpr) - 1;
        it.dil = 1 << lg; it.rr = rg >> lgpr; it.n0 = 4 * (rg & gm); it.nbk = 128 >> lg; it.canmerge = ((rg & gm) != gm) ? 1 : 0;
        it.qoff = 1536 + it.h * 128; it.koff = 3072 + it.h * 128; it.voff = 4608 + it.h * 128; }
}
__device__ __forceinline__ int att_tlo(const AttItem& it) { return it.isNA ? min(max(it.n0 - 4, 0), 120) : max(it.n0 - 1, 0); }
__device__ __forceinline__ void attn_phase(unsigned char* ws_, unsigned char* outb, const float* rpb, LAS unsigned char* lds, int wg, int nwg) {
    const int tid = fresh_tid(), wid = __builtin_amdgcn_readfirstlane(tid >> 6), lane = tid & 63, r32 = lane & 31, hi = lane >> 5;
    const bf16_t* qkv = (const bf16_t*)(ws_ + OFF_X);
    LAS unsigned char* V_lds = lds; LAS unsigned char* K_lds = lds + 32768;
    LAS float* wsf = (LAS float*)(lds + 65536) + wid * 64; LAS float* li_l = wsf; LAS float* al_l = wsf + 32;
    LAS unsigned char* oL = lds + 69888 + wid * 8192;
    LAS unsigned char* qL = oL + lane * 16;
    LAS float* rpbL = (LAS float*)(lds + 65536 + 2048);
    const int sr = tid >> 4, sc = (tid & 15) * 8, vst0 = v_st(sr, sc), vst1 = v_st(32 + sr, sc);
    const int kst0 = KSWZ(sr, sc * 2), kst1 = KSWZ(32 + sr, sc * 2);
    const int vrd = v_rd_base(lane);
    const int qb = wid >> 1, half = wid & 1, iq = 32 * half + r32;
    int vw = wg;
    int gj = -1;
    if (vw >= ATT_NA_ITEMS) return;
    AttItem cur;
#define NEXT_ITEM(ok) do { ok = true; if (gj > 8) { vw += nwg; gj = -1; } \
        if (vw >= ATT_NA_ITEMS) ok = false; \
        else if (gj < 0) { att_decode(vw, cur); gj = 0; } \
        else { att_decode(ATT_NA_ITEMS + 9 * vw + gj, cur); if (cur.canmerge && gj + 1 <= 8) cur.nb4 = 2; gj += cur.nb4; } } while (0)
    bf16x8 qreg[8], ak0, ak1, av0, av1, bk0, bk1, bv0, bv1;
#define LOADQ(it, nq_) do { const bf16_t* qp_ = qkv + ((size_t)(it).b * SEQ + (size_t)((64 * (nq_) + iq) * (it).dil + (it).rr)) * NQKV + (it).qoff + hi * 8; \
        _Pragma("unroll") for (int d0 = 0; d0 < 8; ++d0) qreg[d0] = *(const bf16x8*)(qp_ + d0 * 16); } while (0)
#define SLOAD(S, it, tt) do { const bf16_t* b_ = qkv + (size_t)(it).b * SEQ * NQKV; \
        const size_t t0_ = (size_t)((64 * (tt) + sr) * (it).dil + (it).rr) * NQKV, t1_ = (size_t)((64 * (tt) + 32 + sr) * (it).dil + (it).rr) * NQKV; \
        S##k0 = *(const bf16x8*)(b_ + t0_ + (it).koff + sc); S##k1 = *(const bf16x8*)(b_ + t1_ + (it).koff + sc); \
        S##v0 = *(const bf16x8*)(b_ + t0_ + (it).voff + sc); S##v1 = *(const bf16x8*)(b_ + t1_ + (it).voff + sc); } while (0)
#define SWRITE(S, bf) do { *(LAS bf16x8*)(V_lds + (bf) * 16384 + vst0) = S##v0; *(LAS bf16x8*)(V_lds + (bf) * 16384 + vst1) = S##v1; \
        *(LAS bf16x8*)(K_lds + (bf) * 16384 + kst0) = S##k0; *(LAS bf16x8*)(K_lds + (bf) * 16384 + kst1) = S##k1; } while (0)
#define FINALIZE(nq_) do { \
        bf16_t* ob_; int ostr_; \
        if (isNA) { ob_ = ona_base(outb) + (size_t)b_it * SEQ * 512 + h_it * 128; ostr_ = 512; } \
        else { ob_ = obr_base(ws_, outb, br_it) + (size_t)b_it * SEQ * 1536 + h_it * 128; ostr_ = 1536; } \
        if (!isNA && hi == 0) ((float*)(ws_ + OFF_LSE))[((size_t)br_it * MTOK + (size_t)b_it * SEQ + (size_t)((64 * (nq_) + iq) * dil + rr)) * 12 + h_it] = (m_reg + __log2f(l_reg)) * LN2; \
        if (hi == 0) li_l[r32] = l_reg; \
        asm volatile("s_waitcnt lgkmcnt(0)" ::: "memory"); \
        _Pragma("unroll") for (int r = 0; r < 16; ++r) { const int cr = crow(r, hi); const float rl = fast_rcp(li_l[cr]); \
            LAS bf16_t* op = (LAS bf16_t*)(oL + cr * 256) + r32; \
            _Pragma("unroll") for (int d0 = 0; d0 < 4; ++d0) op[d0 * 32] = (bf16_t)(cvt_pk_bf16(o[d0][r] * rl, 0.f) & 0xffffu); } \
        asm volatile("s_waitcnt lgkmcnt(0)" ::: "memory"); \
        { bf16_t* orow = ob_ + (size_t)((64 * (nq_) + 32 * half + (lane >> 4)) * dil + rr) * ostr_ + (lane & 15) * 8; \
          const size_t ostep = (size_t)4 * dil * ostr_; \
          _Pragma("unroll 2") for (int i = 0; i < 8; ++i) { const int c = lane + 64 * i; *(u32x4*)(orow + i * ostep) = *(const LAS u32x4*)(oL + (c >> 4) * 256 + (c & 15) * 16); } } \
        asm volatile("s_waitcnt lgkmcnt(0)" ::: "memory"); } while (0)
    bool ok0; NEXT_ITEM(ok0);
    LOADQ(cur, cur.n0 + qb); SLOAD(a, cur, att_tlo(cur)); SLOAD(b, cur, att_tlo(cur) + 1);
    for (;;) {
        const bool isNA = cur.isNA != 0; const int dil = cur.dil, rr = cur.rr, n0 = cur.n0, b_it = cur.b, h_it = cur.h, br_it = cur.br, nb4 = cur.nb4;
        int nq = n0 + qb;
        int lo_w, hi_w, t_hi; const int t_lo = att_tlo(cur);
        if (isNA) { const int rs = min(max(nq - 4, 0), 120); lo_w = rs; hi_w = rs + 7; t_hi = min(max(n0 - 1, 0), 120) + 7;
            for (int i = tid; i < 561; i += 512) rpbL[i] = (i >= 48 && i < 513) ? rpb[h_it * 465 + i - 48] * LOG2E : 0.f; }
        else { lo_w = nq - 1; hi_w = nq + 1; t_hi = min(n0 + 4 * nb4, cur.nbk - 1); }
#pragma unroll
        for (int d0 = 0; d0 < 8; ++d0) *(LAS bf16x8*)(qL + d0 * 1024) = qreg[d0];
        SWRITE(a, 0); __syncthreads();
        float m_reg = NEGBIG, l_reg = 0.f; f32x16 o[4] = {};
#define TILE_BODY(tt, buf) do {                                                                                                                 \
            if (nb4 == 2 && (tt) == hi_w + 1 && nq < n0 + 4) {     \
                FINALIZE(nq); nq += 4; lo_w = nq - 1; hi_w = nq + 1; LOADQ(cur, nq);                                                            \
                _Pragma("unroll") for (int d0 = 0; d0 < 8; ++d0) *(LAS bf16x8*)(qL + d0 * 1024) = qreg[d0];                                     \
                m_reg = NEGBIG; l_reg = 0.f; _Pragma("unroll") for (int d = 0; d < 4; ++d) o[d] = f32x16{};                                     \
            }                                                                                                                                   \
            if ((tt) >= lo_w && (tt) <= hi_w) {                                                                                                 \
                f32x16 p0, p1;                                                                                                                  \
                qkt(p0, p1, K_lds + (buf) * 16384, qL, r32, hi);                                                                               \
                if (isNA) {                                                                                                                     \
                    int qs = min(max(iq - 8, 0), 48) - 4 * hi; asm volatile("" : "+v"(qs));     \
                    const LAS float* bp = rpbL + 48 + ((tt) - nq + 7) * 31 + 15 - iq + 4 * hi;                                                  \
                    float bv[16];                                                                                                               \
                    _Pragma("unroll") for (int r = 0; r < 16; ++r) { const int k0 = (r & 3) + 8 * (r >> 2); bv[r] = bp[k0]; }     \
                    _Pragma("unroll") for (int r = 0; r < 16; ++r) { const int k0 = (r & 3) + 8 * (r >> 2);                                     \
                        const float a0 = p0[r] + bv[r]; p0[r] = ((unsigned)(k0 - qs) < 16u) ? a0 : NEGBIG; }                                    \
                    asm volatile("" ::: "memory");                                                                                              \
                    _Pragma("unroll") for (int r = 0; r < 16; ++r) { const int k0 = (r & 3) + 8 * (r >> 2); bv[r] = bp[k0 + 32]; }              \
                    _Pragma("unroll") for (int r = 0; r < 16; ++r) { const int k1 = 32 + (r & 3) + 8 * (r >> 2);                                \
                        const float a1 = p1[r] + bv[r]; p1[r] = ((unsigned)(k1 - qs) < 16u) ? a1 : NEGBIG; }                                    \
                } else if ((tt) != nq) {                                                                                                        \
                    int thr = iq - 4 * hi; asm volatile("" : "+v"(thr));                                                                        \
                    if ((tt) < nq) {                                                                                                            \
                        _Pragma("unroll") for (int r = 0; r < 16; ++r) { const int k0 = (r & 3) + 8 * (r >> 2);                                 \
                            p0[r] = (k0 >= thr) ? p0[r] : NEGBIG; p1[r] = (k0 + 32 >= thr) ? p1[r] : NEGBIG; }                                  \
                    } else {                                                                                                                    \
                        _Pragma("unroll") for (int r = 0; r < 16; ++r) { const int k0 = (r & 3) + 8 * (r >> 2);                                 \
                            p0[r] = (k0 <= thr) ? p0[r] : NEGBIG; p1[r] = (k0 + 32 <= thr) ? p1[r] : NEGBIG; }                                  \
                    }                                                                                                                           \
                }                                                                                                                               \
                float alpha; bf16x8 pa0, pa1, pa2, pa3;                                                                                         \
                softmax_tile(p0, p1, m_reg, l_reg, alpha, pa0, pa1, pa2, pa3);                                                                  \
                if (__any(alpha < 1.f)) { if (hi == 0) al_l[r32] = alpha; asm volatile("s_waitcnt lgkmcnt(0)" ::: "memory");                    \
                    _Pragma("unroll") for (int r = 0; r < 16; ++r) { const float a = al_l[crow(r, hi)];                                         \
                        _Pragma("unroll") for (int d = 0; d < 4; ++d) o[d][r] *= a; } }                                                         \
                const int vb = (int)(size_t)(V_lds + (buf) * 16384) + vrd;                                                                      \
                pv_one<0>(o[0], vb, pa0, pa1, pa2, pa3); pv_one<1>(o[1], vb, pa0, pa1, pa2, pa3); pv_one<2>(o[2], vb, pa0, pa1, pa2, pa3); pv_one<3>(o[3], vb, pa0, pa1, pa2, pa3); \
            } } while (0)
        for (int tt = t_lo; tt <= t_hi; tt += 2) {
            if (tt + 2 <= t_hi) SLOAD(a, cur, tt + 2);
            TILE_BODY(tt, 0);
            if (tt + 1 <= t_hi) SWRITE(b, 1);
            __syncthreads();
            if (tt + 1 > t_hi) break;
            if (tt + 3 <= t_hi) SLOAD(b, cur, tt + 3);
            TILE_BODY(tt + 1, 1);
            if (tt + 2 <= t_hi) SWRITE(a, 0);
            __syncthreads();
        }
#undef TILE_BODY
        FINALIZE(nq);
        bool ok; NEXT_ITEM(ok);
        if (!ok) break;
        LOADQ(cur, cur.n0 + qb); SLOAD(a, cur, att_tlo(cur)); SLOAD(b, cur, att_tlo(cur) + 1);
    }
#undef NEXT_ITEM
#undef FINALIZE
#undef LOADQ
#undef SLOAD
#undef SWRITE
}

__device__ __forceinline__ void merge_phase(unsigned char* ws_, unsigned char* outb, const float* outg_, int wg, int nwg) {
    const int tid = fresh_tid(), lane = tid & 63, gw = wg * 8 + (tid >> 6), NGW = nwg * 8;
    const int h = lane >> 2, q = lane & 3;
    const float* outg = outg_ + h * 128 + q * 32;
    bf16_t* obuf = (bf16_t*)(ws_ + OFF_X);
    for (int tok = gw; tok < MTOK; tok += NGW) {
        float v[32];
        if (h < 4) {
            const u32x4* sp = (const u32x4*)(ona_base(outb) + (size_t)tok * 512 + h * 128 + q * 32);
#pragma unroll
            for (int c = 0; c < 4; ++c) { const u32x4 w = sp[c];
                v[8 * c + 0] = bf_lo(w.x); v[8 * c + 1] = bf_hi(w.x); v[8 * c + 2] = bf_lo(w.y); v[8 * c + 3] = bf_hi(w.y);
                v[8 * c + 4] = bf_lo(w.z); v[8 * c + 5] = bf_hi(w.z); v[8 * c + 6] = bf_lo(w.w); v[8 * c + 7] = bf_hi(w.w); }
        } else {
            const int hd = h - 4; const float* lse = (const float*)(ws_ + OFF_LSE);
            const float l0 = lse[((size_t)0 * MTOK + tok) * 12 + hd], l1 = lse[((size_t)1 * MTOK + tok) * 12 + hd], l2 = lse[((size_t)2 * MTOK + tok) * 12 + hd];
            const float mx = fmaxf(l0, fmaxf(l1, l2));
            float w0 = __expf(l0 - mx), w1 = __expf(l1 - mx), w2 = __expf(l2 - mx);
            const float inv = 1.0f / (w0 + w1 + w2); w0 *= inv; w1 *= inv; w2 *= inv;
#pragma unroll
            for (int i = 0; i < 32; ++i) v[i] = 0.f;
#pragma unroll
            for (int p = 0; p < 3; ++p) { const float wp = (p == 0) ? w0 : (p == 1 ? w1 : w2);
                const u32x4* sp = (const u32x4*)(obr_base(ws_, outb, p) + (size_t)tok * 1536 + hd * 128 + q * 32);
#pragma unroll
                for (int c = 0; c < 4; ++c) { const u32x4 w = sp[c];
                    v[8 * c + 0] += wp * bf_lo(w.x); v[8 * c + 1] += wp * bf_hi(w.x); v[8 * c + 2] += wp * bf_lo(w.y); v[8 * c + 3] += wp * bf_hi(w.y);
                    v[8 * c + 4] += wp * bf_lo(w.z); v[8 * c + 5] += wp * bf_hi(w.z); v[8 * c + 6] += wp * bf_lo(w.w); v[8 * c + 7] += wp * bf_hi(w.w); } }
        }
        float ss = 0.f;
#pragma unroll
        for (int i = 0; i < 32; ++i) ss += v[i] * v[i];
        ss += __shfl_xor(ss, 1); ss += __shfl_xor(ss, 2);
        const float rs = __frsqrt_rn(ss * (1.0f / 128.0f) + EPS);
        u32x4* dp = (u32x4*)(obuf + (size_t)tok * DM + h * 128 + q * 32);
#pragma unroll
        for (int c = 0; c < 4; ++c) { const f32x4 g0 = *(const f32x4*)(outg + 8 * c), g1 = *(const f32x4*)(outg + 8 * c + 4);
            u32x4 w; w.x = cvt_pk_bf16(v[8 * c + 0] * rs * g0[0], v[8 * c + 1] * rs * g0[1]); w.y = cvt_pk_bf16(v[8 * c + 2] * rs * g0[2], v[8 * c + 3] * rs * g0[3]);
            w.z = cvt_pk_bf16(v[8 * c + 4] * rs * g1[0], v[8 * c + 5] * rs * g1[1]); w.w = cvt_pk_bf16(v[8 * c + 6] * rs * g1[2], v[8 * c + 7] * rs * g1[3]);
            dp[c] = w; }
    }
}


#define XB_TMO      128
#define XB_XCNT(j)  (256  + 64 * (j))
#define XB_XSUB(j)  (1280 + 64 * (j))
#define XB_XGEN(j)  (2304 + 64 * (j))
#define XB_TOP      3328
#define XB_TOPGEN   3392
#define XCD_BAR_WORDS 3456
#define XB_SPIN_CAP (1u << 22)
__device__ __forceinline__ unsigned xb_ld(unsigned* p)              { return __hip_atomic_load(p, __ATOMIC_RELAXED, __HIP_MEMORY_SCOPE_AGENT); }
__device__ __forceinline__ unsigned xb_add(unsigned* p, unsigned v) { return __hip_atomic_fetch_add(p, v, __ATOMIC_RELAXED, __HIP_MEMORY_SCOPE_AGENT); }
__device__ __forceinline__ unsigned xb_xcc_id() { return (unsigned)__builtin_amdgcn_s_getreg((3 << 11) | 20) & 0xFu; }
#define XB_SPIN(cond, bar) do { unsigned _sp = 0; while (cond) { __builtin_amdgcn_s_sleep(1); \
    if ((++_sp & 255u) == 0u) { if (xb_ld(&(bar)[XB_TMO])) break; if (_sp > XB_SPIN_CAP) { atomicAdd(&(bar)[XB_TMO], 1u); break; } } } } while (0)
struct XcdBarrier { unsigned* bar; unsigned x; volatile LAS unsigned* st; };
__device__ __forceinline__ XcdBarrier xcd_barrier_post(unsigned* bar, volatile LAS unsigned* st) {
    XcdBarrier b; b.bar = bar; b.x = xb_xcc_id(); b.st = st;
    if (threadIdx.x == 0) (void)xb_add(&bar[XB_XCNT(b.x)], 1u);
    return b;
}
__device__ __forceinline__ void xcd_barrier_complete(unsigned* bar, unsigned x, unsigned& nloc, unsigned& nx) {
    const unsigned G = gridDim.x * gridDim.y * gridDim.z;
    unsigned sum, cnt, mine, sp = 0u;
    for (;;) {
        sum = 0u; cnt = 0u; mine = 0u;
#pragma unroll
        for (unsigned j = 0; j < 16; ++j) { const unsigned c = xb_ld(&bar[XB_XCNT(j)]); sum += c; cnt += (c > 0u) ? 1u : 0u; mine = (j == x) ? c : mine; }
        if (sum == G) break;
        __builtin_amdgcn_s_sleep(1);
        if ((++sp & 255u) == 0u) { if (xb_ld(&bar[XB_TMO])) break; if (sp > XB_SPIN_CAP) { atomicAdd(&bar[XB_TMO], 1u); break; } }
    }
    nloc = mine > 0u ? mine : 1u; nx = cnt > 0u ? cnt : 1u;
}
__device__ __forceinline__ void xcd_barrier(const XcdBarrier& b) {
    asm volatile("s_waitcnt vmcnt(0)" ::: "memory");
    __syncthreads();
    if (threadIdx.x == 0) {
        unsigned* bar = b.bar;
        __builtin_amdgcn_s_waitcnt(0);
        unsigned nloc = b.st[0], nx = b.st[1];
        if (nloc == 0u) { xcd_barrier_complete(bar, b.x, nloc, nx); b.st[0] = nloc; b.st[1] = nx; }
        const unsigned old = xb_add(&bar[XB_XSUB(b.x)], 1u);
        const unsigned gen = old / nloc;
        if (old + 1u == (gen + 1u) * nloc) {
            __builtin_amdgcn_fence(__ATOMIC_RELEASE, "agent");
            asm volatile("s_waitcnt vmcnt(0)" ::: "memory");
            const unsigned og = xb_add(&bar[XB_TOP], 1u);
            const unsigned tg = og / nx;
            if (og + 1u == (tg + 1u) * nx) xb_add(&bar[XB_TOPGEN], 1u);
            else XB_SPIN(xb_ld(&bar[XB_TOPGEN]) == tg, bar);
            __builtin_amdgcn_fence(__ATOMIC_ACQUIRE, "agent");
            xb_add(&bar[XB_XGEN(b.x)], 1u);
            asm volatile("s_waitcnt vmcnt(0)" ::: "memory");
        } else {
            XB_SPIN(xb_ld(&bar[XB_XGEN(b.x)]) == gen, bar);
            __builtin_amdgcn_fence(__ATOMIC_ACQUIRE, "agent");
            asm volatile("s_waitcnt vmcnt(0)" ::: "memory");
        }
    }
    __syncthreads();
}

#ifndef GEMM_REP
#define GEMM_REP 1
#endif
#ifndef ATT_REP
#define ATT_REP 1
#endif
#ifndef PHMASK
#define PHMASK 0xffffffffu
#endif
constexpr unsigned PH = PHMASK;
constexpr int LDS_XB = 69888 + 65536;
constexpr int LDS_BYTES = LDS_XB + 16;
typedef const __attribute__((address_space(4))) unsigned long long* kargp_t;
__device__ __forceinline__ unsigned long long karg_q(int i) { return *(volatile kargp_t)((kargp_t)__builtin_amdgcn_kernarg_segment_ptr() + i); }
#define GAS __attribute__((address_space(1)))
#define PIN(i) ((const float*)(const GAS float*)karg_q(i))
#define POUT ((float*)(GAS float*)karg_q(22))
#define PWS ((unsigned char*)(GAS unsigned char*)karg_q(23))
__global__ __launch_bounds__(512, 2) void fwd_megakernel(Params P) {
    extern __shared__ __attribute__((aligned(16))) unsigned char smem[];
    LAS unsigned char* lds = (LAS unsigned char*)smem;
    cg::grid_group grid = cg::this_grid();
    const int wg = blockIdx.x, nwg = gridDim.x;
    if (threadIdx.x < 4) ((LAS unsigned*)(lds + LDS_XB))[threadIdx.x] = 0u;
    __syncthreads();
    if (nwg == 0x7fffffff) grid.sync();
    const XcdBarrier xb = xcd_barrier_post((unsigned*)(PWS + OFF_BAR), (volatile LAS unsigned*)(lds + LDS_XB));
    unsigned char* ws = PWS;
    bf16_t* HB = (bf16_t*)(ws + OFF_HB); float* RS = (float*)(ws + OFF_RS); bf16_t* F = (bf16_t*)(ws + OFF_F); bf16_t* PPb = (bf16_t*)(ws + OFF_PP); bf16_t* X = (bf16_t*)(ws + OFF_X);
    pg8::StaticOrder S;

    if (PH & (1u << 0)) {
    { CvtDesc d{PIN(3), PIN(4), (bf16_t*)(ws + OFF_W1A), DM, DFF, 2 * DFF, 1, PIN(2)}; cvt_run(d, lds, wg, nwg); }
    { CvtDesc d{PIN(5), nullptr, (bf16_t*)(ws + OFF_W1B), DFF, DM, DM, 0, nullptr}; cvt_run(d, lds, wg, nwg); }
    { CvtDesc d{PIN(8), nullptr, (bf16_t*)(ws + OFF_WQKV), DM, NQKV, NQKV, 2, PIN(7)}; cvt_run(d, lds, wg, nwg); }
    { CvtDesc d{PIN(11), nullptr, (bf16_t*)(ws + OFF_WO), DM, DM, DM, 0, nullptr}; cvt_run(d, lds, wg, nwg); }
    { float* rc = (float*)(ws + OFF_ROPE); float* rsn = rc + SEQ * 64;
      for (int i = wg * 512 + fresh_tid(); i < SEQ * 64; i += nwg * 512) { const int pos = i >> 6, k = i & 63;
          const float inv = exp2f(-(float)k * (13.287712379549449f / 64.0f)); const float ang = (float)pos * inv;
          double rev = (double)ang * 0.15915494309189535; rev -= floor(rev); const float fr = (float)rev;
          rc[i] = __builtin_amdgcn_cosf(fr); rsn[i] = __builtin_amdgcn_sinf(fr); } }
    { const f32x4* pp = (const f32x4*)PIN(1); u32x2* po = (u32x2*)(ws + OFF_PBF);
      for (int i = wg * 512 + fresh_tid(); i < MTOK * PLE / 4; i += nwg * 512) { const f32x4 v = __builtin_nontemporal_load(pp + i); u32x2 w; w.x = cvt_pk_bf16(v[0], v[1]); w.y = cvt_pk_bf16(v[2], v[3]); po[i] = w; } }
    rowwise_phase<0>(PIN(0), HB, nullptr, nullptr, 0.f, RS, nullptr, wg, nwg);
    }
    xcd_barrier(xb);
    for (int rep_ = 0; rep_ < GEMM_REP; ++rep_) if (PH & (1u << 1)) {
    { pg8::Gemm g{HB, (const bf16_t*)(ws + OFF_W1A), MTOK, 2 * DFF, DM}; S.init(MTOK, 2 * DFF, nwg, wg); pg8::EpiSwiglu E{X, RS}; pg8::gemm_phase(lds, g, S, E); }
    }
    xcd_barrier(xb);
    for (int rep_ = 0; rep_ < GEMM_REP; ++rep_) if (PH & (1u << 2)) {
    { pg8::Gemm g{X, (const bf16_t*)(ws + OFF_W1B), MTOK, DM, DFF}; S.init(MTOK, DM, nwg, wg); pg8::EpiPlain E{F, DM}; pg8::gemm_phase(lds, g, S, E); }
    }
    xcd_barrier(xb);
    if (PH & (1u << 3)) {
    rowwise_phase<3>(nullptr, HB, F, PIN(6), 0.5f, RS, nullptr, wg, nwg);
    { CvtDesc d{PIN(14), PIN(15), (bf16_t*)(ws + OFF_W1A), DM, DFF, 2 * DFF, 1, PIN(13)}; cvt_run(d, lds, wg, nwg); }
    { CvtDesc d{PIN(16), nullptr, (bf16_t*)(ws + OFF_W1B), DFF, DM, DM, 0, nullptr}; cvt_run(d, lds, wg, nwg); }
    }
    xcd_barrier(xb);
    for (int rep_ = 0; rep_ < GEMM_REP; ++rep_) if (PH & (1u << 4)) {
    { pg8::Gemm g{HB, (const bf16_t*)(ws + OFF_WQKV), MTOK, NQKV, DM}; S.init(MTOK, NQKV, nwg, wg);
      pg8::EpiQkv E{X, (const float*)(ws + OFF_ROPE), (const float*)(ws + OFF_ROPE) + SEQ * 64, RS}; pg8::gemm_phase(lds, g, S, E); }
    }
    xcd_barrier(xb);
    for (int rep_ = 0; rep_ < ATT_REP; ++rep_) if (PH & (1u << 5)) {
    attn_phase(ws, (unsigned char*)POUT, PIN(9), lds, wg, nwg);
    }
    xcd_barrier(xb);
    if (PH & (1u << 6)) {
    merge_phase(ws, (unsigned char*)POUT, PIN(10), wg, nwg);
    { CvtDesc d{PIN(19), nullptr, (bf16_t*)(ws + OFF_WPG), DM, DM, DM, 0, PIN(18)}; cvt_run(d, lds, wg, nwg); }
    { CvtDesc d{PIN(20), nullptr, (bf16_t*)(ws + OFF_WPP), PLE, DM, DM, 0, nullptr}; cvt_run(d, lds, wg, nwg); }
    }
    xcd_barrier(xb);
    for (int rep_ = 0; rep_ < GEMM_REP; ++rep_) if (PH & (1u << 7)) {
    { pg8::Gemm g{X, (const bf16_t*)(ws + OFF_WO), MTOK, DM, DM}; S.init(MTOK, DM, nwg, wg); pg8::EpiPlain E{F, DM}; pg8::gemm_phase(lds, g, S, E); }
    }
    xcd_barrier(xb);
    if (PH & (1u << 8)) {
    rowwise_phase<3>(nullptr, HB, F, PIN(12), 1.0f, RS, nullptr, wg, nwg);
    }
    xcd_barrier(xb);
    for (int rep_ = 0; rep_ < GEMM_REP; ++rep_) if (PH & (1u << 9)) {
    { pg8::Gemm g{(const bf16_t*)(ws + OFF_PBF), (const bf16_t*)(ws + OFF_WPP), MTOK, DM, PLE}; S.init(MTOK, DM, nwg, wg); pg8::EpiPlain E{PPb, DM}; pg8::gemm_phase(lds, g, S, E); }
    __syncthreads();
    { pg8::Gemm g{HB, (const bf16_t*)(ws + OFF_W1A), MTOK, 2 * DFF, DM}; S.init(MTOK, 2 * DFF, nwg, wg); pg8::EpiSwiglu E{X, RS}; pg8::gemm_phase(lds, g, S, E); }
    }
    xcd_barrier(xb);
    for (int rep_ = 0; rep_ < GEMM_REP; ++rep_) if (PH & (1u << 10)) {
    { pg8::Gemm g{X, (const bf16_t*)(ws + OFF_W1B), MTOK, DM, DFF}; S.init(MTOK, DM, nwg, wg); pg8::EpiPlain E{F, DM}; pg8::gemm_phase(lds, g, S, E); }
    }
    xcd_barrier(xb);
    if (PH & (1u << 11)) {
    rowwise_phase<3>(nullptr, HB, F, PIN(17), 0.5f, RS, nullptr, wg, nwg);
    }
    xcd_barrier(xb);
    for (int rep_ = 0; rep_ < GEMM_REP; ++rep_) if (PH & (1u << 12)) {
    { pg8::Gemm g{HB, (const bf16_t*)(ws + OFF_WPG), MTOK, DM, DM}; S.init(MTOK, DM, nwg, wg); pg8::EpiPle E{F, PPb, RS}; pg8::gemm_phase(lds, g, S, E); }
    }
    xcd_barrier(xb);
    if (PH & (1u << 13)) {
    rowwise_phase<2>(nullptr, HB, F, PIN(21), 1.0f, nullptr, POUT, wg, nwg);
    }
}

extern "C" void kernel_launch(void* const* d_in, const int* in_sizes, int n_in, void* d_out, int out_size, void* d_ws, size_t ws_size, hipStream_t stream) {
    static int grid_blocks = 0;
    if (grid_blocks == 0) {
        if (n_in != 22 || ws_size < WS_END) { fprintf(stderr, "kernel_launch: unexpected n_in %d or ws_size %zu (< %zu)\n", n_in, ws_size, (size_t)WS_END); grid_blocks = -1; return; }
        int dev = 0, cus = 0, per_cu = 0;
        hipGetDevice(&dev);
        hipDeviceGetAttribute(&cus, hipDeviceAttributeMultiprocessorCount, dev);
        hipFuncSetAttribute((const void*)fwd_megakernel, hipFuncAttributeMaxDynamicSharedMemorySize, LDS_BYTES);
        hipOccupancyMaxActiveBlocksPerMultiprocessor(&per_cu, (const void*)fwd_megakernel, 512, LDS_BYTES);
        if (per_cu < 1) per_cu = 1;
        grid_blocks = cus * (per_cu > 1 ? 1 : per_cu);
        (void)hipGetLastError();
    }
    if (grid_blocks < 0) return;
    Params p{};
    for (int i = 0; i < 22; ++i) p.in[i] = (const float*)d_in[i];
    p.out = (float*)d_out; p.ws = (unsigned char*)d_ws;
    (void)hipMemsetAsync((unsigned char*)d_ws + OFF_BAR, 0, XCD_BAR_WORDS * 4, stream);
    void* args[] = {&p};
    hipError_t e = hipLaunchCooperativeKernel((const void*)fwd_megakernel, dim3(grid_blocks), dim3(512), args, LDS_BYTES, stream);
    if (e != hipSuccess) fprintf(stderr, "cooperative launch failed: %s (grid %d)\n", hipGetErrorString(e), grid_blocks);
}
```

```cpp
#include <hip/hip_runtime.h>
#include <hip/hip_cooperative_groups.h>
#include <cstdio>
namespace cg = cooperative_groups;

#define LAS __attribute__((address_space(3)))
typedef unsigned short bf16_t;
typedef short bf16x8 __attribute__((ext_vector_type(8)));
typedef short s16x4 __attribute__((ext_vector_type(4)));
typedef float f32x4 __attribute__((ext_vector_type(4)));
typedef float f32x16 __attribute__((ext_vector_type(16)));
typedef unsigned u32x4 __attribute__((ext_vector_type(4)));
typedef unsigned u32x2 __attribute__((ext_vector_type(2)));

constexpr int MTOK = 16384, SEQ = 8192, DM = 2048, DFF = 5632, NQKV = 6144, PLE = 256;
constexpr float EPS = 1e-6f;
constexpr float LOG2E = 1.4426950408889634f, LN2 = 0.6931471805599453f;
constexpr float QSCALE = 0.088388347648318440f * 1.4426950408889634f;
constexpr float NEGBIG = -1e30f;

constexpr size_t MiB = (size_t)1 << 20;
constexpr size_t OFF_W1A = 0;
constexpr size_t OFF_W1B = OFF_W1A + (size_t)11264 * 2048 * 2;
constexpr size_t OFF_W2A = OFF_W1B + (size_t)2048 * 5632 * 2;
constexpr size_t OFF_W2B = OFF_W2A + (size_t)11264 * 2048 * 2;
constexpr size_t OFF_WQKV = OFF_W2B + (size_t)2048 * 5632 * 2;
constexpr size_t OFF_WO = OFF_WQKV + (size_t)6144 * 2048 * 2;
constexpr size_t OFF_WPG = OFF_WO + (size_t)2048 * 2048 * 2;
constexpr size_t OFF_WPP = OFF_WPG + (size_t)2048 * 2048 * 2;
constexpr size_t OFF_ROPE = OFF_WPP + (size_t)2048 * 256 * 2;
constexpr size_t OFF_PBF = OFF_ROPE + (size_t)8192 * 64 * 4 * 2;
constexpr size_t OFF_LSE = OFF_PBF + (size_t)MTOK * 256 * 2;
constexpr size_t OFF_RS = OFF_LSE + (size_t)3 * MTOK * 12 * 4;
constexpr size_t OFF_HB = OFF_RS + (size_t)MTOK * 4;
constexpr size_t OFF_F = OFF_HB + (size_t)MTOK * 2048 * 2;
constexpr size_t OFF_X = OFF_F + (size_t)MTOK * 2048 * 2;
constexpr size_t XG_BYTES = (size_t)SEQ * 6144 * 2;
constexpr size_t OFF_BAR = OFF_X + 2 * XG_BYTES;
constexpr size_t WS_END = OFF_BAR + 65536;
constexpr size_t OBRG_BYTES = (size_t)SEQ * 1536 * 2;
static_assert(OBRG_BYTES <= (size_t)SEQ * 2048 * 2 && 2 * OBRG_BYTES + (size_t)SEQ * 512 * 2 <= (size_t)SEQ * DM * 4, "attention scratch must fit in the batch's halves of F and d_out");
static_assert(WS_END <= (size_t)512 * 1024 * 1024, "workspace");
__device__ __forceinline__ bf16_t* obr_base(unsigned char* ws_, unsigned char* outb, int g, int p) {
    return (bf16_t*)(p == 0 ? ws_ + OFF_F + (size_t)g * ((size_t)SEQ * 2048 * 2) : outb + (size_t)g * ((size_t)SEQ * DM * 4) + (size_t)(p - 1) * OBRG_BYTES); }
__device__ __forceinline__ bf16_t* ona_base(unsigned char* outb, int g) { return (bf16_t*)(outb + (size_t)g * ((size_t)SEQ * DM * 4) + 2 * OBRG_BYTES); }

struct Params { const float* in[22]; float* out; unsigned char* ws; };

__device__ __forceinline__ unsigned cvt_pk_bf16(float lo, float hi) { unsigned r; asm volatile("v_cvt_pk_bf16_f32 %0, %1, %2" : "=v"(r) : "v"(lo), "v"(hi)); return r; }
__device__ __forceinline__ float bf_lo(unsigned w) { return __uint_as_float(w << 16); }
__device__ __forceinline__ float bf_hi(unsigned w) { return __uint_as_float(w & 0xffff0000u); }
__device__ __forceinline__ float wave_sum(float v) {
#pragma unroll
    for (int o = 1; o < 64; o <<= 1) v += __shfl_xor(v, o);
    return v;
}
__device__ __forceinline__ int fresh_tid() { int t = threadIdx.x; asm volatile("" : "+v"(t)); return t; }
__device__ __forceinline__ float fast_rcp(float x) { return __builtin_amdgcn_rcpf(x); }
__device__ __forceinline__ float fast_exp2(float x) { return __builtin_amdgcn_exp2f(x); }

namespace pg8 {
constexpr int BM = 256, BK = 64, HALF = 128, HTB = HALF * BK * 2, STAGE_BYTES = 8 * HTB, NXCD = 8, WGM = 8;
__device__ __forceinline__ int lds_byte(int r, int c) { const int st = (r >> 4) * 2 + (c >> 5), rr = r & 15, cc = c & 31, ob = rr * 64 + cc * 2; return st * 1024 + (ob ^ (((ob >> 9) & 1) << 5)); }
__device__ __forceinline__ void stage_rc(int b, int& R, int& C) { const int st = b / 1024, sb = b % 1024, swz = sb ^ (((sb >> 9) & 1) << 5); R = (st >> 1) * 16 + swz / 64; C = (st & 1) * 32 + (swz % 64) / 2; }
__device__ __forceinline__ int perm32(int rho) { const int n = rho >> 4, i = rho & 15; return 8 * (i >> 2) + 4 * n + (i & 3); }
struct Unit { int pm, pn; };
struct Gemm { const bf16_t* A; const bf16_t* Bt; int M, N, K; };
struct StaticOrder {
    int nM, nN, nwg, G, c;
    __device__ void init(int M, int N, int G_, int c_) { nM = M / BM; nN = N / BM; nwg = nM * nN; G = G_; c = c_; }
    __device__ bool next(int i, Unit& u) const {
        const long L = (long)i * G + c; if (L >= nwg) return false;
        int wgid = (int)L; { const int q = nwg / NXCD, r = nwg % NXCD, xcd = wgid % NXCD, off = wgid / NXCD; wgid = (xcd < r ? xcd * (q + 1) : r * (q + 1) + (xcd - r) * q) + off; }
        const int nig = WGM * nN, gid = wgid / nig, fm = gid * WGM, gsz = (nM - fm) < WGM ? (nM - fm) : WGM;
        u.pm = fm + ((wgid % nig) % gsz); u.pn = (wgid % nig) / gsz; return true;
    }
};

template <class Epi>
__device__ __forceinline__ void gemm_phase(LAS unsigned char* lds, const Gemm g, const StaticOrder& S, const Epi& E) {
    const int tid = fresh_tid(), wid = __builtin_amdgcn_readfirstlane(tid >> 6), lane = tid & 63, wr = wid >> 2, wc = wid & 3, fr = lane & 15, fq = lane >> 4;
    const int K = g.K, nt = K / BK;
    unsigned voffA[2], voffB[2];
#pragma unroll
    for (int i = 0; i < 2; ++i) { int R, C; stage_rc(tid * 16 + i * 8192, R, C); const int Rb = (R & ~31) + perm32(R & 31);
        voffA[i] = (unsigned)(R * K + C) * 2u; voffB[i] = (unsigned)(Rb * K + C) * 2u; }
    const size_t kstep = (size_t)(BK * 2);
    const size_t hstep = (size_t)HALF * K * 2;
    const size_t tstep = 2 * hstep;
    const unsigned ldsw = (unsigned)wid * 1024u;
    const int aoff = lds_byte(wr * 64 + fr, fq * 8), boff = lds_byte(wc * 32 + fr, fq * 8);
#define PG8_SA(b, h) (((b) * 2 + (h)) * HTB)
#define PG8_SB(b, h) ((4 + (b) * 2 + (h)) * HTB)
#define PG8_STAGE(bufoff, gbase, voff) do { _Pragma("unroll") for (int _i = 0; _i < 2; ++_i) \
        __builtin_amdgcn_global_load_lds((const unsigned*)((const char*)(gbase) + (voff)[_i]), (LAS unsigned*)(lds + (bufoff) + ldsw + _i * 8192), 16, 0, 0); } while (0)
#define PG8_LDA(dst, b, h) do { _Pragma("unroll") for (int m = 0; m < 4; ++m) _Pragma("unroll") for (int k = 0; k < 2; ++k) dst[m][k] = *(const LAS bf16x8*)(lds + PG8_SA(b, h) + aoff + m * 2048 + k * 1024); } while (0)
#define PG8_LDB(dst, b, h) do { _Pragma("unroll") for (int n = 0; n < 2; ++n) _Pragma("unroll") for (int k = 0; k < 2; ++k) dst[n][k] = *(const LAS bf16x8*)(lds + PG8_SB(b, h) + boff + n * 2048 + k * 1024); } while (0)
#define PG8_MMA(ai, bj, At, Bt) do { __builtin_amdgcn_s_setprio(1); _Pragma("unroll") for (int m = 0; m < 4; ++m) _Pragma("unroll") for (int n = 0; n < 2; ++n) _Pragma("unroll") for (int k = 0; k < 2; ++k) \
        acc[ai][bj][m][n] = __builtin_amdgcn_mfma_f32_16x16x32_bf16(Bt[n][k], At[m][k], acc[ai][bj][m][n], 0, 0, 0); __builtin_amdgcn_s_setprio(0); } while (0)
#define PG8_WAIT_V(n) asm volatile("s_waitcnt vmcnt(" #n ")" ::: "memory")
#define PG8_WAIT_L(n) asm volatile("s_waitcnt lgkmcnt(" #n ")" ::: "memory")
#define PG8_BAR __builtin_amdgcn_s_barrier()
#define PG8_SCHED __builtin_amdgcn_sched_barrier(0)
    Unit cur, nxt; int ui = 0;
    if (!S.next(0, cur)) return;
    f32x4 acc[2][2][4][2];
#pragma unroll
    for (int a = 0; a < 2; ++a)
#pragma unroll
        for (int b = 0; b < 2; ++b)
#pragma unroll
            for (int m = 0; m < 4; ++m)
#pragma unroll
                for (int n = 0; n < 2; ++n) acc[a][b][m][n] = (f32x4){0.f, 0.f, 0.f, 0.f};
    bf16x8 At[4][2], B0[2][2], B1[2][2];
    const char* cA = (const char*)g.A + (size_t)cur.pm * tstep; const char* cB = (const char*)g.Bt + (size_t)cur.pn * tstep;
    PG8_STAGE(PG8_SB(0, 0), cB, voffB); PG8_STAGE(PG8_SA(0, 0), cA, voffA); PG8_STAGE(PG8_SB(0, 1), cB + hstep, voffB); PG8_STAGE(PG8_SA(0, 1), cA + hstep, voffA);
    if (wr == 1) PG8_BAR;
    PG8_WAIT_V(4); PG8_BAR;
    PG8_STAGE(PG8_SB(1, 0), cB + kstep, voffB); PG8_STAGE(PG8_SA(1, 0), cA + kstep, voffA); PG8_STAGE(PG8_SB(1, 1), cB + hstep + kstep, voffB);
    PG8_WAIT_V(6); PG8_BAR;
    for (;;) {
        const bool has_next = S.next(ui + 1, nxt);
        const char* nA = has_next ? (const char*)g.A + (size_t)nxt.pm * tstep : cA; const char* nB = has_next ? (const char*)g.Bt + (size_t)nxt.pn * tstep : cB;
        for (int t = 0; t < nt; t += 2) {
            const bool last = (t == nt - 2);
            const char* a1 = cA + (size_t)(t + 1) * kstep;
            const char* a2 = last ? nA : cA + (size_t)(t + 2) * kstep; const char* b2 = last ? nB : cB + (size_t)(t + 2) * kstep;
            const char* a3 = a2 + kstep; const char* b3 = b2 + kstep;
            PG8_LDB(B0, 0, 0); PG8_SCHED; PG8_LDA(At, 0, 0); PG8_STAGE(PG8_SA(1, 1), a1 + hstep, voffA);
            PG8_WAIT_L(8); PG8_BAR; PG8_WAIT_L(0); PG8_MMA(0, 0, At, B0); PG8_BAR; PG8_SCHED;
            PG8_LDB(B1, 0, 1); PG8_STAGE(PG8_SB(0, 0), b2, voffB);
            PG8_BAR; PG8_WAIT_L(0); PG8_MMA(0, 1, At, B1); PG8_BAR;
            PG8_LDA(At, 0, 1); PG8_STAGE(PG8_SA(0, 0), a2, voffA);
            PG8_BAR; PG8_WAIT_L(0); PG8_MMA(1, 0, At, B0); PG8_BAR; PG8_SCHED;
            PG8_STAGE(PG8_SB(0, 1), b2 + hstep, voffB);
            PG8_WAIT_V(6); PG8_BAR; PG8_MMA(1, 1, At, B1); PG8_BAR;
            PG8_LDB(B0, 1, 0); PG8_SCHED; PG8_LDA(At, 1, 0); PG8_STAGE(PG8_SA(0, 1), a2 + hstep, voffA);
            PG8_WAIT_L(8); PG8_BAR; PG8_WAIT_L(0); PG8_MMA(0, 0, At, B0); PG8_BAR; PG8_SCHED;
            PG8_LDB(B1, 1, 1); PG8_STAGE(PG8_SB(1, 0), b3, voffB);
            PG8_BAR; PG8_WAIT_L(0); PG8_MMA(0, 1, At, B1); PG8_BAR;
            PG8_LDA(At, 1, 1); PG8_STAGE(PG8_SA(1, 0), a3, voffA);
            PG8_BAR; PG8_WAIT_L(0); PG8_MMA(1, 0, At, B0); PG8_BAR; PG8_SCHED;
            PG8_STAGE(PG8_SB(1, 1), b3 + hstep, voffB);
            PG8_WAIT_V(6); PG8_BAR; PG8_MMA(1, 1, At, B1); PG8_BAR;
        }
        E(acc, cur, wr, wc, fr, fq);
        if (!has_next) break;
#pragma unroll
        for (int a = 0; a < 2; ++a)
#pragma unroll
            for (int b = 0; b < 2; ++b)
#pragma unroll
                for (int m = 0; m < 4; ++m)
#pragma unroll
                    for (int n = 0; n < 2; ++n) acc[a][b][m][n] = (f32x4){0.f, 0.f, 0.f, 0.f};
        cur = nxt; cA = nA; cB = nB; ++ui;
    }
    PG8_WAIT_V(0);
    if (wr == 0) PG8_BAR;
    PG8_BAR;
#undef PG8_SA
#undef PG8_SB
#undef PG8_STAGE
#undef PG8_LDA
#undef PG8_LDB
#undef PG8_MMA
#undef PG8_WAIT_V
#undef PG8_WAIT_L
#undef PG8_BAR
#undef PG8_SCHED
}

__device__ __forceinline__ u32x4 pack8(f32x4 v0, f32x4 v1) { u32x4 w; w.x = cvt_pk_bf16(v0[0], v0[1]); w.y = cvt_pk_bf16(v0[2], v0[3]); w.z = cvt_pk_bf16(v1[0], v1[1]); w.w = cvt_pk_bf16(v1[2], v1[3]); return w; }

struct EpiPlain {
    bf16_t* O; int ldc;
    __device__ __forceinline__ void operator()(const f32x4 (&acc)[2][2][4][2], const Unit& u, int wr, int wc, int fr, int fq) const {
        const int row0 = u.pm * BM + wr * 64 + fr, col0 = u.pn * BM + wc * 32 + 8 * fq;
#pragma unroll
        for (int ai = 0; ai < 2; ++ai)
#pragma unroll
            for (int m = 0; m < 4; ++m) { bf16_t* rowp = O + (size_t)(row0 + ai * HALF + m * 16) * ldc + col0;
#pragma unroll
                for (int bj = 0; bj < 2; ++bj) *(u32x4*)(rowp + bj * HALF) = pack8(acc[ai][bj][m][0], acc[ai][bj][m][1]); }
    }
};
struct EpiSwiglu {
    bf16_t* O; const float* rs;
    __device__ __forceinline__ void operator()(const f32x4 (&acc)[2][2][4][2], const Unit& u, int wr, int wc, int fr, int fq) const {
        const int row0 = u.pm * BM + wr * 64 + fr, col0 = u.pn * HALF + wc * 32 + 8 * fq;
#pragma unroll
        for (int ai = 0; ai < 2; ++ai)
#pragma unroll
            for (int m = 0; m < 4; ++m) { bf16_t* rowp = O + (size_t)(row0 + ai * HALF + m * 16) * DFF + col0;
                const float r = rs[row0 + ai * HALF + m * 16], r2 = r * r;
                f32x4 h0, h1;
#pragma unroll
                for (int j = 0; j < 4; ++j) {
                    const float g0 = acc[ai][0][m][0][j], g1 = acc[ai][0][m][1][j];
                    h0[j] = g0 * r2 * fast_rcp(1.0f + fast_exp2(g0 * (-LOG2E * r))) * acc[ai][1][m][0][j];
                    h1[j] = g1 * r2 * fast_rcp(1.0f + fast_exp2(g1 * (-LOG2E * r))) * acc[ai][1][m][1][j]; }
                *(u32x4*)rowp = pack8(h0, h1); }
    }
};
struct EpiQkv {
    bf16_t* O; const float* rc; const float* rs; const float* rowsc;
    __device__ __forceinline__ void operator()(const f32x4 (&acc)[2][2][4][2], const Unit& u, int wr, int wc, int fr, int fq) const {
        const int row0 = u.pm * BM + wr * 64 + fr;
        if (u.pn >= 6 && u.pn < 18) {
            const int d0 = 32 * (wc & 1) + 8 * fq, col1 = u.pn * BM + HALF * (wc >> 1) + d0;
            const float sc = (u.pn < 12) ? QSCALE : 1.0f;
#pragma unroll
            for (int ai = 0; ai < 2; ++ai)
#pragma unroll
                for (int m = 0; m < 4; ++m) { const int row = row0 + ai * HALF + m * 16; const int pos = row & (SEQ - 1); const float scr_ = sc * rowsc[row];
                    const f32x4 c0 = *(const f32x4*)(rc + pos * 64 + d0), c1 = *(const f32x4*)(rc + pos * 64 + d0 + 4);
                    const f32x4 s0 = *(const f32x4*)(rs + pos * 64 + d0), s1 = *(const f32x4*)(rs + pos * 64 + d0 + 4);
                    const f32x4 a0 = acc[ai][0][m][0], a1 = acc[ai][0][m][1], b0 = acc[ai][1][m][0], b1 = acc[ai][1][m][1];
                    const f32x4 o10 = (a0 * c0 - b0 * s0) * scr_, o11 = (a1 * c1 - b1 * s1) * scr_;
                    const f32x4 o20 = (b0 * c0 + a0 * s0) * scr_, o21 = (b1 * c1 + a1 * s1) * scr_;
                    bf16_t* rowp = O + (size_t)row * NQKV + col1;
                    *(u32x4*)rowp = pack8(o10, o11); *(u32x4*)(rowp + 64) = pack8(o20, o21); }
        } else {
            const int col0 = u.pn * BM + wc * 32 + 8 * fq; const float sc = (u.pn < 2) ? QSCALE : 1.0f;
#pragma unroll
            for (int ai = 0; ai < 2; ++ai)
#pragma unroll
                for (int m = 0; m < 4; ++m) { bf16_t* rowp = O + (size_t)(row0 + ai * HALF + m * 16) * NQKV + col0; const float scr_ = sc * rowsc[row0 + ai * HALF + m * 16];
#pragma unroll
                    for (int bj = 0; bj < 2; ++bj) *(u32x4*)(rowp + bj * HALF) = pack8(acc[ai][bj][m][0] * scr_, acc[ai][bj][m][1] * scr_); }
        }
    }
};
struct EpiPle {
    bf16_t* O; const bf16_t* PP; const float* rs;
    __device__ __forceinline__ void operator()(const f32x4 (&acc)[2][2][4][2], const Unit& u, int wr, int wc, int fr, int fq) const {
        const int row0 = u.pm * BM + wr * 64 + fr, col0 = u.pn * BM + wc * 32 + 8 * fq;
#pragma unroll
        for (int ai = 0; ai < 2; ++ai)
#pragma unroll
            for (int m = 0; m < 4; ++m) { const size_t ro = (size_t)(row0 + ai * HALF + m * 16) * DM + col0; const float nr = -LOG2E * rs[row0 + ai * HALF + m * 16];
#pragma unroll
                for (int bj = 0; bj < 2; ++bj) {
                    const u32x4 pw = *(const u32x4*)(PP + ro + bj * HALF);
                    const float pv[8] = {bf_lo(pw.x), bf_hi(pw.x), bf_lo(pw.y), bf_hi(pw.y), bf_lo(pw.z), bf_hi(pw.z), bf_lo(pw.w), bf_hi(pw.w)};
                    f32x4 t0, t1;
#pragma unroll
                    for (int j = 0; j < 4; ++j) {
                        t0[j] = fast_rcp(1.0f + fast_exp2(acc[ai][bj][m][0][j] * nr)) * pv[j];
                        t1[j] = fast_rcp(1.0f + fast_exp2(acc[ai][bj][m][1][j] * nr)) * pv[4 + j]; }
                    *(u32x4*)(O + ro + bj * HALF) = pack8(t0, t1); } }
    }
};
}

struct CvtDesc { const float* W0; const float* W1; bf16_t* Bt; int K, Nsrc, nslots, mode; const float* gk; };
struct CvtPos { int k0, s0, c0; const float* W; };
__device__ __forceinline__ CvtPos cvt_pos(const CvtDesc& d, int item) {
    const int nblk = d.nslots >> 5, kb = item / nblk, nb = item - kb * nblk; CvtPos p; p.k0 = 64 * kb; p.s0 = 32 * nb; p.W = d.W0; p.c0 = p.s0;
    if (d.mode == 1) { const int tile = p.s0 >> 8, bj = (p.s0 >> 7) & 1, q = p.s0 & 127; p.W = bj ? d.W1 : d.W0; p.c0 = tile * 128 + q; }
    else if (d.mode == 2) { const int pn = p.s0 >> 8; if (pn >= 6 && pn < 18) { const int bj = (p.s0 >> 7) & 1, q = p.s0 & 127; p.c0 = pn * 256 + 128 * (q >> 6) + 64 * bj + (q & 63); } }
    return p;
}
__device__ __forceinline__ void cvt_load(const CvtDesc& d, const CvtPos& p, f32x4 (&v)[8], int lane) {
    const int rr8 = lane >> 3, c4 = (lane & 7) * 4;
    const float* src = p.W + (size_t)(p.k0 + rr8) * d.Nsrc + p.c0 + c4;
#pragma unroll
    for (int i = 0; i < 8; ++i) v[i] = *(const f32x4*)(src + (size_t)(8 * i) * d.Nsrc);
}
__device__ __forceinline__ void cvt_store(const CvtDesc& d, const CvtPos& p, f32x4 (&v)[8], LAS float* scr, int lane) {
    const int rr8 = lane >> 3, c4 = (lane & 7) * 4, k0 = p.k0, s0 = p.s0;
    if (d.gk) {
#pragma unroll
        for (int i = 0; i < 8; ++i) v[i] *= d.gk[k0 + 8 * i + rr8]; }
#pragma unroll
    for (int i = 0; i < 8; ++i) { LAS float* wp = scr + (8 * i + rr8) * 33 + c4; wp[0] = v[i][0]; wp[1] = v[i][1]; wp[2] = v[i][2]; wp[3] = v[i][3]; }
    asm volatile("s_waitcnt lgkmcnt(0)" ::: "memory");
    const int c = lane & 7;
#pragma unroll
    for (int j = 0; j < 4; ++j) { const int n = (lane >> 3) + 8 * j; const LAS float* s = scr + (8 * c) * 33 + n;
        u32x4 o; o.x = cvt_pk_bf16(s[0 * 33], s[1 * 33]); o.y = cvt_pk_bf16(s[2 * 33], s[3 * 33]); o.z = cvt_pk_bf16(s[4 * 33], s[5 * 33]); o.w = cvt_pk_bf16(s[6 * 33], s[7 * 33]);
        *(u32x4*)(d.Bt + (size_t)(s0 + n) * d.K + k0 + 8 * c) = o; }
    asm volatile("s_waitcnt lgkmcnt(0)" ::: "memory");
}
__device__ __forceinline__ void cvt_run(const CvtDesc& d, LAS unsigned char* lds, int wg, int nwg) {
    const int tid = fresh_tid(), wid = tid >> 6, lane = tid & 63, gw = wg * 8 + wid, NGW = nwg * 8; LAS float* scr = (LAS float*)(lds + wid * 8704);
    const int nitems = (d.K >> 6) * (d.nslots >> 5);
    int it = gw; if (it >= nitems) return;
    f32x4 vN[8]; CvtPos pN = cvt_pos(d, it); cvt_load(d, pN, vN, lane);
    for (; it < nitems; it += NGW) {
        f32x4 v[8]; const CvtPos p = pN;
#pragma unroll
        for (int i = 0; i < 8; ++i) v[i] = vN[i];
        if (it + NGW < nitems) { pN = cvt_pos(d, it + NGW); cvt_load(d, pN, vN, lane); }
        cvt_store(d, p, v, scr, lane);
    }
}

template <int MODE>
__device__ __forceinline__ void rowwise_phase(const float* xin, bf16_t* hb, const bf16_t* f, const float* gpost, float alpha, float* rsout, float* fout, int wg, int nwg, int row0, int rowend) {
    const int tid = fresh_tid(), lane = tid & 63, gw = row0 + wg * 8 + (tid >> 6), NGW = nwg * 8;
    constexpr bool XIN = (MODE == 0 || MODE == 1), HASF = (MODE != 0);
    f32x4 xN[8]; u32x2 hN[8], fN[8];
#define ROW_LOAD(r_) do { \
        if (XIN) { const f32x4* xp_ = (const f32x4*)(xin + (size_t)(r_) * DM) + lane; _Pragma("unroll") for (int j = 0; j < 8; ++j) xN[j] = xp_[64 * j]; } \
        else { const u32x2* hp_ = (const u32x2*)(hb + (size_t)(r_) * DM) + lane; _Pragma("unroll") for (int j = 0; j < 8; ++j) hN[j] = hp_[64 * j]; } \
        if (HASF) { const u32x2* fp_ = (const u32x2*)(f + (size_t)(r_) * DM) + lane; _Pragma("unroll") for (int j = 0; j < 8; ++j) fN[j] = fp_[64 * j]; } } while (0)
    if (gw < rowend) ROW_LOAD(gw);
    for (int row = gw; row < rowend; row += NGW) {
        f32x4 h[8]; u32x2 fw[8];
#pragma unroll
        for (int j = 0; j < 8; ++j) { if (XIN) h[j] = xN[j]; else h[j] = (f32x4){bf_lo(hN[j].x), bf_hi(hN[j].x), bf_lo(hN[j].y), bf_hi(hN[j].y)}; if (HASF) fw[j] = fN[j]; }
        const int nrow = row + NGW;
        if (nrow < rowend) ROW_LOAD(nrow);
        if (HASF) {
            f32x4 fv[8]; float ss = 0.f;
#pragma unroll
            for (int j = 0; j < 8; ++j) { const u32x2 w = fw[j]; fv[j] = (f32x4){bf_lo(w.x), bf_hi(w.x), bf_lo(w.y), bf_hi(w.y)};
                ss += (fv[j][0] * fv[j][0] + fv[j][1] * fv[j][1]) + (fv[j][2] * fv[j][2] + fv[j][3] * fv[j][3]); }
            ss = wave_sum(ss);
            const float rs = alpha * __frsqrt_rn(ss * (1.0f / DM) + EPS);
#pragma unroll
            for (int j = 0; j < 8; ++j) { const f32x4 g = ((const f32x4*)gpost)[lane + 64 * j]; h[j] += fv[j] * g * rs; }
        }
        if (MODE == 2) {
            f32x4* op = (f32x4*)(fout + (size_t)row * DM) + lane;
#pragma unroll
            for (int j = 0; j < 8; ++j) op[64 * j] = h[j];
        } else {
            float s2 = 0.f;
#pragma unroll
            for (int j = 0; j < 8; ++j) s2 += (h[j][0] * h[j][0] + h[j][1] * h[j][1]) + (h[j][2] * h[j][2] + h[j][3] * h[j][3]);
            s2 = wave_sum(s2);
            if (lane == 0) rsout[row] = __frsqrt_rn(s2 * (1.0f / DM) + EPS);
            u32x2* up = (u32x2*)(hb + (size_t)row * DM) + lane;
#pragma unroll
            for (int j = 0; j < 8; ++j) { u32x2 w; w.x = cvt_pk_bf16(h[j][0], h[j][1]); w.y = cvt_pk_bf16(h[j][2], h[j][3]); up[64 * j] = w; }
        }
    }
#undef ROW_LOAD
}

#define KSWZ(row, colB) ((row) * 256 + ((colB) ^ (((row) & 7) << 4)))
#define SBAR() __builtin_amdgcn_sched_barrier(0)
__device__ __forceinline__ int crow(int r, int hi) { return (r & 3) + 8 * (r >> 2) + 4 * hi; }
__device__ __forceinline__ int v_st(int k, int c) { const int kk = (k & ~0xC) | ((k & 4) << 1) | ((k & 8) >> 1); return ((kk >> 3) * 4 + (c >> 5)) * 512 + ((kk & 7) * 32 + (c & 31)) * 2; }
__device__ __forceinline__ int v_rd_base(int lane) { return ((lane & 3) << 3) | (((lane >> 2) & 3) << 6) | (((lane >> 4) & 1) << 5) | (((lane >> 5) & 1) << 8); }
constexpr int v_rd_off(int d0, int ks, int half) { return d0 * 512 + ks * 4096 + half * 2048; }
template <int OFF> __device__ __forceinline__ s16x4 tr_read(int vb) {
    s16x4 r; asm volatile("ds_read_b64_tr_b16 %0, %1 offset:%2" : "=&v"(r) : "v"(vb), "i"(OFF) : "memory"); return r;
}
template <int D0> __device__ __forceinline__ void pv_one(f32x16& od, int vb, bf16x8 pa0, bf16x8 pa1, bf16x8 pa2, bf16x8 pa3) {
    const s16x4 l0 = tr_read<v_rd_off(D0, 0, 0)>(vb), h0 = tr_read<v_rd_off(D0, 0, 1)>(vb), l1 = tr_read<v_rd_off(D0, 1, 0)>(vb), h1 = tr_read<v_rd_off(D0, 1, 1)>(vb);
    const s16x4 l2 = tr_read<v_rd_off(D0, 2, 0)>(vb), h2 = tr_read<v_rd_off(D0, 2, 1)>(vb), l3 = tr_read<v_rd_off(D0, 3, 0)>(vb), h3 = tr_read<v_rd_off(D0, 3, 1)>(vb);
    asm volatile("s_waitcnt lgkmcnt(0)" ::: "memory"); SBAR();
#define PK(L, H) (bf16x8){L[0], L[1], L[2], L[3], H[0], H[1], H[2], H[3]}
    od = __builtin_amdgcn_mfma_f32_32x32x16_bf16(pa0, PK(l0, h0), od, 0, 0, 0);
    od = __builtin_amdgcn_mfma_f32_32x32x16_bf16(pa1, PK(l1, h1), od, 0, 0, 0);
    od = __builtin_amdgcn_mfma_f32_32x32x16_bf16(pa2, PK(l2, h2), od, 0, 0, 0);
    od = __builtin_amdgcn_mfma_f32_32x32x16_bf16(pa3, PK(l3, h3), od, 0, 0, 0);
#undef PK
}
__device__ __forceinline__ void qkt(f32x16& p0, f32x16& p1, const LAS unsigned char* Ks, const LAS unsigned char* qL, int r32, int hi) {
    p0 = f32x16{}; p1 = f32x16{};
#pragma unroll
    for (int d0 = 0; d0 < 8; ++d0) { const int cb = (d0 * 16 + hi * 8) * 2;
        const bf16x8 b0 = *(const LAS bf16x8*)(Ks + KSWZ(r32, cb));
        const bf16x8 b1 = *(const LAS bf16x8*)(Ks + KSWZ(32 + r32, cb));
        const bf16x8 q = *(const LAS bf16x8*)(qL + d0 * 1024);
        p0 = __builtin_amdgcn_mfma_f32_32x32x16_bf16(b0, q, p0, 0, 0, 0);
        p1 = __builtin_amdgcn_mfma_f32_32x32x16_bf16(b1, q, p1, 0, 0, 0); }
}
__device__ __forceinline__ void softmax_tile(f32x16& p0, f32x16& p1, float& m_reg, float& l_reg, float& alpha, bf16x8& pa0, bf16x8& pa1, bf16x8& pa2, bf16x8& pa3) {
    float pmax = p0[0];
#pragma unroll
    for (int r = 1; r < 16; ++r) pmax = fmaxf(pmax, p0[r]);
#pragma unroll
    for (int r = 0; r < 16; ++r) pmax = fmaxf(pmax, p1[r]);
    { auto rr = __builtin_amdgcn_permlane32_swap(__float_as_uint(pmax), __float_as_uint(pmax), false, false);
      pmax = fmaxf(__uint_as_float(rr[0]), __uint_as_float(rr[1])); }
    const float mn = (pmax > m_reg + 8.0f) ? pmax : m_reg;
    alpha = fast_exp2(m_reg - mn); m_reg = mn;
#pragma unroll
    for (int r = 0; r < 16; ++r) { p0[r] = fast_exp2(p0[r] - mn); p1[r] = fast_exp2(p1[r] - mn); }
    float ps = 0.f;
#pragma unroll
    for (int r = 0; r < 16; ++r) ps += p0[r];
#pragma unroll
    for (int r = 0; r < 16; ++r) ps += p1[r];
    { auto rr = __builtin_amdgcn_permlane32_swap(__float_as_uint(ps), __float_as_uint(ps), false, false);
      ps = __uint_as_float(rr[0]) + __uint_as_float(rr[1]); }
    l_reg = l_reg * alpha + ps;
#define PK4(P, BASE, OUT) do { unsigned a0 = cvt_pk_bf16(P[BASE + 0], P[BASE + 1]), a1 = cvt_pk_bf16(P[BASE + 2], P[BASE + 3]);   \
    unsigned b0 = cvt_pk_bf16(P[BASE + 4], P[BASE + 5]), b1 = cvt_pk_bf16(P[BASE + 6], P[BASE + 7]);                              \
    auto r0 = __builtin_amdgcn_permlane32_swap(a0, b0, false, false); auto r1 = __builtin_amdgcn_permlane32_swap(a1, b1, false, false); \
    u32x4 w = {r0[0], r1[0], r0[1], r1[1]}; OUT = *reinterpret_cast<bf16x8*>(&w); } while (0)
    PK4(p0, 0, pa0); PK4(p0, 8, pa1); PK4(p1, 0, pa2); PK4(p1, 8, pa3);
#undef PK4
}

constexpr int ATT_NA_ITEMS = 256, ATT_ITEMS = 256 + 2304;
struct AttItem { int isNA, b, h, dil, rr, n0, nbk, qoff, koff, voff, br, nb4, canmerge; };
__device__ __forceinline__ void att_decode(int item, AttItem& it) {
    it.nb4 = 1; it.canmerge = 0;
    if (item < ATT_NA_ITEMS) { it.isNA = 1; it.b = item >> 7; it.h = (item >> 5) & 3; it.dil = 1; it.rr = 0; it.n0 = 4 * (item & 31); it.nbk = 128; it.br = 0;
        it.qoff = it.h * 128; it.koff = 512 + it.h * 128; it.voff = 1024 + it.h * 128; }
    else { const int id = item - ATT_NA_ITEMS; it.isNA = 0; it.br = id / 768; int rem = id - it.br * 768; it.b = rem / 384; rem -= it.b * 384; it.h = rem >> 5; const int rg = rem & 31;
        const int lg = 2 * it.br, lgpr = 5 - lg, gm = (1 << lgpr) - 1;
        it.dil = 1 << lg; it.rr = rg >> lgpr; it.n0 = 4 * (rg & gm); it.nbk = 128 >> lg; it.canmerge = ((rg & gm) != gm) ? 1 : 0;
        it.qoff = 1536 + it.h * 128; it.koff = 3072 + it.h * 128; it.voff = 4608 + it.h * 128; }
}
__device__ __forceinline__ int att_tlo(const AttItem& it) { return it.isNA ? min(max(it.n0 - 4, 0), 120) : max(it.n0 - 1, 0); }
__device__ __forceinline__ void attn_phase(unsigned char* ws_, unsigned char* outb, const float* rpb, LAS unsigned char* lds, int wg, int nwg, int grp) {
    const int tid = fresh_tid(), wid = __builtin_amdgcn_readfirstlane(tid >> 6), lane = tid & 63, r32 = lane & 31, hi = lane >> 5;
    const bf16_t* qkv = (const bf16_t*)(ws_ + OFF_X + (size_t)grp * XG_BYTES);
    LAS unsigned char* V_lds = lds; LAS unsigned char* K_lds = lds + 32768;
    LAS float* wsf = (LAS float*)(lds + 65536) + wid * 64; LAS float* li_l = wsf; LAS float* al_l = wsf + 32;
    LAS unsigned char* oL = lds + 69888 + wid * 8192;
    LAS unsigned char* qL = oL + lane * 16;
    LAS float* rpbL = (LAS float*)(lds + 65536 + 2048);
    const int sr = tid >> 4, sc = (tid & 15) * 8, vst0 = v_st(sr, sc), vst1 = v_st(32 + sr, sc);
    const int kst0 = KSWZ(sr, sc * 2), kst1 = KSWZ(32 + sr, sc * 2);
    const int vrd = v_rd_base(lane);
    const int qb = wid >> 1, half = wid & 1, iq = 32 * half + r32;
    int vw = wg;
    int gj = -1;
    if (vw >= 128) return;
    AttItem cur;
#define NEXT_ITEM(ok) do { ok = true; if (gj > 8) { vw += nwg; gj = -1; } \
        if (vw >= 128) ok = false; \
        else if (gj < 0) { att_decode(grp * 128 + vw, cur); gj = 0; } \
        else { const int ix_ = 9 * vw + gj, br_ = ix_ / 384; att_decode(ATT_NA_ITEMS + br_ * 768 + grp * 384 + (ix_ - br_ * 384), cur); if (cur.canmerge && gj + 1 <= 8) cur.nb4 = 2; gj += cur.nb4; } } while (0)
    bf16x8 qreg[8], ak0, ak1, av0, av1, bk0, bk1, bv0, bv1;
#define LOADQ(it, nq_) do { const bf16_t* qp_ = qkv + (size_t)((64 * (nq_) + iq) * (it).dil + (it).rr) * NQKV + (it).qoff + hi * 8; \
        _Pragma("unroll") for (int d0 = 0; d0 < 8; ++d0) qreg[d0] = *(const bf16x8*)(qp_ + d0 * 16); } while (0)
#define SLOAD(S, it, tt) do { const bf16_t* b_ = qkv; \
        const size_t t0_ = (size_t)((64 * (tt) + sr) * (it).dil + (it).rr) * NQKV, t1_ = (size_t)((64 * (tt) + 32 + sr) * (it).dil + (it).rr) * NQKV; \
        S##k0 = *(const bf16x8*)(b_ + t0_ + (it).koff + sc); S##k1 = *(const bf16x8*)(b_ + t1_ + (it).koff + sc); \
        S##v0 = *(const bf16x8*)(b_ + t0_ + (it).voff + sc); S##v1 = *(const bf16x8*)(b_ + t1_ + (it).voff + sc); } while (0)
#define SWRITE(S, bf) do { *(LAS bf16x8*)(V_lds + (bf) * 16384 + vst0) = S##v0; *(LAS bf16x8*)(V_lds + (bf) * 16384 + vst1) = S##v1; \
        *(LAS bf16x8*)(K_lds + (bf) * 16384 + kst0) = S##k0; *(LAS bf16x8*)(K_lds + (bf) * 16384 + kst1) = S##k1; } while (0)
#define FINALIZE(nq_) do { \
        bf16_t* ob_; int ostr_; \
        if (isNA) { ob_ = ona_base(outb, grp) + h_it * 128; ostr_ = 512; } \
        else { ob_ = obr_base(ws_, outb, grp, br_it) + h_it * 128; ostr_ = 1536; } \
        if (!isNA && hi == 0) ((float*)(ws_ + OFF_LSE))[((size_t)br_it * MTOK + (size_t)b_it * SEQ + (size_t)((64 * (nq_) + iq) * dil + rr)) * 12 + h_it] = (m_reg + __log2f(l_reg)) * LN2; \
        if (hi == 0) li_l[r32] = l_reg; \
        asm volatile("s_waitcnt lgkmcnt(0)" ::: "memory"); \
        _Pragma("unroll") for (int r = 0; r < 16; ++r) { const int cr = crow(r, hi); const float rl = fast_rcp(li_l[cr]); \
            LAS bf16_t* op = (LAS bf16_t*)(oL + cr * 256) + r32; \
            _Pragma("unroll") for (int d0 = 0; d0 < 4; ++d0) op[d0 * 32] = (bf16_t)(cvt_pk_bf16(o[d0][r] * rl, 0.f) & 0xffffu); } \
        asm volatile("s_waitcnt lgkmcnt(0)" ::: "memory"); \
        { bf16_t* orow = ob_ + (size_t)((64 * (nq_) + 32 * half + (lane >> 4)) * dil + rr) * ostr_ + (lane & 15) * 8; \
          const size_t ostep = (size_t)4 * dil * ostr_; \
          _Pragma("unroll 2") for (int i = 0; i < 8; ++i) { const int c = lane + 64 * i; *(u32x4*)(orow + i * ostep) = *(const LAS u32x4*)(oL + (c >> 4) * 256 + (c & 15) * 16); } } \
        asm volatile("s_waitcnt lgkmcnt(0)" ::: "memory"); } while (0)
    bool ok0; NEXT_ITEM(ok0);
    LOADQ(cur, cur.n0 + qb); SLOAD(a, cur, att_tlo(cur)); SLOAD(b, cur, att_tlo(cur) + 1);
    for (;;) {
        const bool isNA = cur.isNA != 0; const int dil = cur.dil, rr = cur.rr, n0 = cur.n0, b_it = cur.b, h_it = cur.h, br_it = cur.br, nb4 = cur.nb4;
        int nq = n0 + qb;
        int lo_w, hi_w, t_hi; const int t_lo = att_tlo(cur);
        if (isNA) { const int rs = min(max(nq - 4, 0), 120); lo_w = rs; hi_w = rs + 7; t_hi = min(max(n0 - 1, 0), 120) + 7;
            for (int i = tid; i < 561; i += 512) rpbL[i] = (i >= 48 && i < 513) ? rpb[h_it * 465 + i - 48] * LOG2E : 0.f; }
        else { lo_w = nq - 1; hi_w = nq + 1; t_hi = min(n0 + 4 * nb4, cur.nbk - 1); }
#pragma unroll
        for (int d0 = 0; d0 < 8; ++d0) *(LAS bf16x8*)(qL + d0 * 1024) = qreg[d0];
        SWRITE(a, 0); __syncthreads();
        float m_reg = NEGBIG, l_reg = 0.f; f32x16 o[4] = {};
#define TILE_BODY(tt, buf) do {                                                                                                                 \
            if (nb4 == 2 && (tt) == hi_w + 1 && nq < n0 + 4) {     \
                FINALIZE(nq); nq += 4; lo_w = nq - 1; hi_w = nq + 1; LOADQ(cur, nq);                                                            \
                _Pragma("unroll") for (int d0 = 0; d0 < 8; ++d0) *(LAS bf16x8*)(qL + d0 * 1024) = qreg[d0];                                     \
                m_reg = NEGBIG; l_reg = 0.f; _Pragma("unroll") for (int d = 0; d < 4; ++d) o[d] = f32x16{};                                     \
            }                                                                                                                                   \
            if ((tt) >= lo_w && (tt) <= hi_w) {                                                                                                 \
                f32x16 p0, p1;                                                                                                                  \
                qkt(p0, p1, K_lds + (buf) * 16384, qL, r32, hi);                                                                               \
                if (isNA) {                                                                                                                     \
                    int qs = min(max(iq - 8, 0), 48) - 4 * hi; asm volatile("" : "+v"(qs));     \
                    const LAS float* bp = rpbL + 48 + ((tt) - nq + 7) * 31 + 15 - iq + 4 * hi;                                                  \
                    float bv[16];                                                                                                               \
                    _Pragma("unroll") for (int r = 0; r < 16; ++r) { const int k0 = (r & 3) + 8 * (r >> 2); bv[r] = bp[k0]; }     \
                    _Pragma("unroll") for (int r = 0; r < 16; ++r) { const int k0 = (r & 3) + 8 * (r >> 2);                                     \
                        const float a0 = p0[r] + bv[r]; p0[r] = ((unsigned)(k0 - qs) < 16u) ? a0 : NEGBIG; }                                    \
                    asm volatile("" ::: "memory");                                                                                              \
                    _Pragma("unroll") for (int r = 0; r < 16; ++r) { const int k0 = (r & 3) + 8 * (r >> 2); bv[r] = bp[k0 + 32]; }              \
                    _Pragma("unroll") for (int r = 0; r < 16; ++r) { const int k1 = 32 + (r & 3) + 8 * (r >> 2);                                \
                        const float a1 = p1[r] + bv[r]; p1[r] = ((unsigned)(k1 - qs) < 16u) ? a1 : NEGBIG; }                                    \
                } else if ((tt) != nq) {                                                                                                        \
                    int thr = iq - 4 * hi; asm volatile("" : "+v"(thr));                                                                        \
                    if ((tt) < nq) {                                                                                                            \
                        _Pragma("unroll") for (int r = 0; r < 16; ++r) { const int k0 = (r & 3) + 8 * (r >> 2);                                 \
                            p0[r] = (k0 >= thr) ? p0[r] : NEGBIG; p1[r] = (k0 + 32 >= thr) ? p1[r] : NEGBIG; }                                  \
                    } else {                                                                                                                    \
                        _Pragma("unroll") for (int r = 0; r < 16; ++r) { const int k0 = (r & 3) + 8 * (r >> 2);                                 \
                            p0[r] = (k0 <= thr) ? p0[r] : NEGBIG; p1[r] = (k0 + 32 <= thr) ? p1[r] : NEGBIG; }                                  \
                    }                                                                                                                           \
                }                                                                                                                               \
                float alpha; bf16x8 pa0, pa1, pa2, pa3;                                                                                         \
                softmax_tile(p0, p1, m_reg, l_reg, alpha, pa0, pa1, pa2, pa3);                                                                  \
                if (__any(alpha < 1.f)) { if (hi == 0) al_l[r32] = alpha; asm volatile("s_waitcnt lgkmcnt(0)" ::: "memory");                    \
                    _Pragma("unroll") for (int r = 0; r < 16; ++r) { const float a = al_l[crow(r, hi)];                                         \
                        _Pragma("unroll") for (int d = 0; d < 4; ++d) o[d][r] *= a; } }                                                         \
                const int vb = (int)(size_t)(V_lds + (buf) * 16384) + vrd;                                                                      \
                pv_one<0>(o[0], vb, pa0, pa1, pa2, pa3); pv_one<1>(o[1], vb, pa0, pa1, pa2, pa3); pv_one<2>(o[2], vb, pa0, pa1, pa2, pa3); pv_one<3>(o[3], vb, pa0, pa1, pa2, pa3); \
            } } while (0)
        for (int tt = t_lo; tt <= t_hi; tt += 2) {
            if (tt + 2 <= t_hi) SLOAD(a, cur, tt + 2);
            TILE_BODY(tt, 0);
            if (tt + 1 <= t_hi) SWRITE(b, 1);
            __syncthreads();
            if (tt + 1 > t_hi) break;
            if (tt + 3 <= t_hi) SLOAD(b, cur, tt + 3);
            TILE_BODY(tt + 1, 1);
            if (tt + 2 <= t_hi) SWRITE(a, 0);
            __syncthreads();
        }
#undef TILE_BODY
        FINALIZE(nq);
        bool ok; NEXT_ITEM(ok);
        if (!ok) break;
        LOADQ(cur, cur.n0 + qb); SLOAD(a, cur, att_tlo(cur)); SLOAD(b, cur, att_tlo(cur) + 1);
    }
#undef NEXT_ITEM
#undef FINALIZE
#undef LOADQ
#undef SLOAD
#undef SWRITE
}

__device__ __forceinline__ void merge_phase(unsigned char* ws_, unsigned char* outb, const float* outg_, int wg, int nwg, int grp) {
    const int tid = fresh_tid(), lane = tid & 63, gw = wg * 8 + (tid >> 6), NGW = nwg * 8;
    const int h = lane >> 2, q = lane & 3;
    const float* outg = outg_ + h * 128 + q * 32;
    bf16_t* obuf = (bf16_t*)(ws_ + OFF_X + (size_t)grp * XG_BYTES);
    for (int tok = gw; tok < SEQ; tok += NGW) {
        float v[32];
        if (h < 4) {
            const u32x4* sp = (const u32x4*)(ona_base(outb, grp) + (size_t)tok * 512 + h * 128 + q * 32);
#pragma unroll
            for (int c = 0; c < 4; ++c) { const u32x4 w = sp[c];
                v[8 * c + 0] = bf_lo(w.x); v[8 * c + 1] = bf_hi(w.x); v[8 * c + 2] = bf_lo(w.y); v[8 * c + 3] = bf_hi(w.y);
                v[8 * c + 4] = bf_lo(w.z); v[8 * c + 5] = bf_hi(w.z); v[8 * c + 6] = bf_lo(w.w); v[8 * c + 7] = bf_hi(w.w); }
        } else {
            const int hd = h - 4; const float* lse = (const float*)(ws_ + OFF_LSE);
            const size_t gt = (size_t)grp * SEQ + tok;
            const float l0 = lse[((size_t)0 * MTOK + gt) * 12 + hd], l1 = lse[((size_t)1 * MTOK + gt) * 12 + hd], l2 = lse[((size_t)2 * MTOK + gt) * 12 + hd];
            const float mx = fmaxf(l0, fmaxf(l1, l2));
            float w0 = __expf(l0 - mx), w1 = __expf(l1 - mx), w2 = __expf(l2 - mx);
            const float inv = 1.0f / (w0 + w1 + w2); w0 *= inv; w1 *= inv; w2 *= inv;
#pragma unroll
            for (int i = 0; i < 32; ++i) v[i] = 0.f;
#pragma unroll
            for (int p = 0; p < 3; ++p) { const float wp = (p == 0) ? w0 : (p == 1 ? w1 : w2);
                const u32x4* sp = (const u32x4*)(obr_base(ws_, outb, grp, p) + (size_t)tok * 1536 + hd * 128 + q * 32);
#pragma unroll
                for (int c = 0; c < 4; ++c) { const u32x4 w = sp[c];
                    v[8 * c + 0] += wp * bf_lo(w.x); v[8 * c + 1] += wp * bf_hi(w.x); v[8 * c + 2] += wp * bf_lo(w.y); v[8 * c + 3] += wp * bf_hi(w.y);
                    v[8 * c + 4] += wp * bf_lo(w.z); v[8 * c + 5] += wp * bf_hi(w.z); v[8 * c + 6] += wp * bf_lo(w.w); v[8 * c + 7] += wp * bf_hi(w.w); } }
        }
        float ss = 0.f;
#pragma unroll
        for (int i = 0; i < 32; ++i) ss += v[i] * v[i];
        ss += __shfl_xor(ss, 1); ss += __shfl_xor(ss, 2);
        const float rs = __frsqrt_rn(ss * (1.0f / 128.0f) + EPS);
        u32x4* dp = (u32x4*)(obuf + (size_t)tok * DM + h * 128 + q * 32);
#pragma unroll
        for (int c = 0; c < 4; ++c) { const f32x4 g0 = *(const f32x4*)(outg + 8 * c), g1 = *(const f32x4*)(outg + 8 * c + 4);
            u32x4 w; w.x = cvt_pk_bf16(v[8 * c + 0] * rs * g0[0], v[8 * c + 1] * rs * g0[1]); w.y = cvt_pk_bf16(v[8 * c + 2] * rs * g0[2], v[8 * c + 3] * rs * g0[3]);
            w.z = cvt_pk_bf16(v[8 * c + 4] * rs * g1[0], v[8 * c + 5] * rs * g1[1]); w.w = cvt_pk_bf16(v[8 * c + 6] * rs * g1[2], v[8 * c + 7] * rs * g1[3]);
            dp[c] = w; }
    }
}


#define XB_TMO      128
#define XB_XCNT(j)  (256  + 64 * (j))
#define XB_XSUB(j)  (1280 + 64 * (j))
#define XB_XGEN(j)  (2304 + 64 * (j))
#define XB_TOP      3328
#define XB_TOPGEN   3392
#define XCD_BAR_WORDS 3456
#define XB_SPIN_CAP (1u << 22)
__device__ __forceinline__ unsigned xb_ld(unsigned* p)              { return __hip_atomic_load(p, __ATOMIC_RELAXED, __HIP_MEMORY_SCOPE_AGENT); }
__device__ __forceinline__ unsigned xb_add(unsigned* p, unsigned v) { return __hip_atomic_fetch_add(p, v, __ATOMIC_RELAXED, __HIP_MEMORY_SCOPE_AGENT); }
__device__ __forceinline__ unsigned xb_xcc_id() { return (unsigned)__builtin_amdgcn_s_getreg((3 << 11) | 20) & 0xFu; }
#define XB_SPIN(cond, bar) do { unsigned _sp = 0; while (cond) { __builtin_amdgcn_s_sleep(1); \
    if ((++_sp & 255u) == 0u) { if (xb_ld(&(bar)[XB_TMO])) break; if (_sp > XB_SPIN_CAP) { atomicAdd(&(bar)[XB_TMO], 1u); break; } } } } while (0)
struct XcdBarrier { unsigned* bar; unsigned x; volatile LAS unsigned* st; unsigned G; };
__device__ __forceinline__ XcdBarrier xcd_barrier_post(unsigned* bar, volatile LAS unsigned* st, unsigned G) {
    XcdBarrier b; b.bar = bar; b.x = xb_xcc_id(); b.st = st; b.G = G;
    if (threadIdx.x == 0) (void)xb_add(&bar[XB_XCNT(b.x)], 1u);
    return b;
}
__device__ __forceinline__ void xcd_barrier_complete(unsigned* bar, unsigned x, unsigned& nloc, unsigned& nx, const unsigned G) {
    unsigned sum, cnt, mine, sp = 0u;
    for (;;) {
        sum = 0u; cnt = 0u; mine = 0u;
#pragma unroll
        for (unsigned j = 0; j < 16; ++j) { const unsigned c = xb_ld(&bar[XB_XCNT(j)]); sum += c; cnt += (c > 0u) ? 1u : 0u; mine = (j == x) ? c : mine; }
        if (sum == G) break;
        __builtin_amdgcn_s_sleep(1);
        if ((++sp & 255u) == 0u) { if (xb_ld(&bar[XB_TMO])) break; if (sp > XB_SPIN_CAP) { atomicAdd(&bar[XB_TMO], 1u); break; } }
    }
    nloc = mine > 0u ? mine : 1u; nx = cnt > 0u ? cnt : 1u;
}
__device__ __forceinline__ void xcd_barrier(const XcdBarrier& b) {
    asm volatile("s_waitcnt vmcnt(0)" ::: "memory");
    __syncthreads();
    if (threadIdx.x == 0) {
        unsigned* bar = b.bar;
        __builtin_amdgcn_s_waitcnt(0);
        unsigned nloc = b.st[0], nx = b.st[1];
        if (nloc == 0u) { xcd_barrier_complete(bar, b.x, nloc, nx, b.G); b.st[0] = nloc; b.st[1] = nx; }
        const unsigned old = xb_add(&bar[XB_XSUB(b.x)], 1u);
        const unsigned gen = old / nloc;
        if (old + 1u == (gen + 1u) * nloc) {
            __builtin_amdgcn_fence(__ATOMIC_RELEASE, "agent");
            asm volatile("s_waitcnt vmcnt(0)" ::: "memory");
            const unsigned og = xb_add(&bar[XB_TOP], 1u);
            const unsigned tg = og / nx;
            if (og + 1u == (tg + 1u) * nx) xb_add(&bar[XB_TOPGEN], 1u);
            else XB_SPIN(xb_ld(&bar[XB_TOPGEN]) == tg, bar);
            __builtin_amdgcn_fence(__ATOMIC_ACQUIRE, "agent");
            xb_add(&bar[XB_XGEN(b.x)], 1u);
            asm volatile("s_waitcnt vmcnt(0)" ::: "memory");
        } else {
            XB_SPIN(xb_ld(&bar[XB_XGEN(b.x)]) == gen, bar);
            __builtin_amdgcn_fence(__ATOMIC_ACQUIRE, "agent");
            asm volatile("s_waitcnt vmcnt(0)" ::: "memory");
        }
    }
    __syncthreads();
}

#ifndef GEMM_REP
#define GEMM_REP 1
#endif
#ifndef ATT_REP
#define ATT_REP 1
#endif
#ifndef PHMASK
#define PHMASK 0xffffffffu
#endif
constexpr unsigned PH = PHMASK;
constexpr int LDS_XB = 69888 + 65536;
constexpr int LDS_BYTES = LDS_XB + 16;
typedef const __attribute__((address_space(4))) unsigned long long* kargp_t;
__device__ __forceinline__ unsigned long long karg_q(int i) { return *(volatile kargp_t)((kargp_t)__builtin_amdgcn_kernarg_segment_ptr() + i); }
#define GAS __attribute__((address_space(1)))
#define PIN(i) ((const float*)(const GAS float*)karg_q(i))
#define POUT ((float*)(GAS float*)karg_q(22))
#define PWS ((unsigned char*)(GAS unsigned char*)karg_q(23))
__global__ __launch_bounds__(512, 2) void fwd_megakernel(Params P) {
    extern __shared__ __attribute__((aligned(16))) unsigned char smem[];
    LAS unsigned char* lds = (LAS unsigned char*)smem;
    cg::grid_group grid = cg::this_grid();
    const int wg = blockIdx.x, nwg = gridDim.x;
    if (threadIdx.x < 4) ((LAS unsigned*)(lds + LDS_XB))[threadIdx.x] = 0u;
    __syncthreads();
    if (nwg == 0x7fffffff) grid.sync();
    const int grp = (wg & 7) >> 2, gi = ((wg >> 3) << 2) | (wg & 3), ng = nwg >> 1;
    unsigned char* ws = PWS;
    const XcdBarrier xb = xcd_barrier_post((unsigned*)(ws + OFF_BAR), (volatile LAS unsigned*)(lds + LDS_XB), (unsigned)nwg);
    const XcdBarrier xg = xcd_barrier_post((unsigned*)(ws + OFF_BAR + 16384 * (1 + grp)), (volatile LAS unsigned*)(lds + LDS_XB) + 2, (unsigned)ng);
    unsigned* wflag = (unsigned*)(ws + OFF_BAR + 49152);
    const int row0 = grp * SEQ;
    bf16_t* HB = (bf16_t*)(ws + OFF_HB); float* RS = (float*)(ws + OFF_RS); bf16_t* F = (bf16_t*)(ws + OFF_F);
    bf16_t* HBg = HB + (size_t)row0 * DM; float* RSg = RS + row0; bf16_t* Fg = F + (size_t)row0 * DM;
    bf16_t* Xg = (bf16_t*)(ws + OFF_X + (size_t)grp * XG_BYTES);
    pg8::StaticOrder S;

    { CvtDesc d{PIN(3), PIN(4), (bf16_t*)(ws + OFF_W1A), DM, DFF, 2 * DFF, 1, PIN(2)}; cvt_run(d, lds, wg, nwg); }
    { float* rc = (float*)(ws + OFF_ROPE); float* rsn = rc + SEQ * 64;
      for (int i = wg * 512 + fresh_tid(); i < SEQ * 64; i += nwg * 512) { const int pos = i >> 6, k = i & 63;
          const float inv = exp2f(-(float)k * (13.287712379549449f / 64.0f)); const float ang = (float)pos * inv;
          double rev = (double)ang * 0.15915494309189535; rev -= floor(rev); const float fr = (float)rev;
          rc[i] = __builtin_amdgcn_cosf(fr); rsn[i] = __builtin_amdgcn_sinf(fr); } }
    { const f32x4* pp = (const f32x4*)PIN(1); u32x2* po = (u32x2*)(ws + OFF_PBF);
      for (int i = wg * 512 + fresh_tid(); i < MTOK * PLE / 4; i += nwg * 512) { const f32x4 v = pp[i]; u32x2 w; w.x = cvt_pk_bf16(v[0], v[1]); w.y = cvt_pk_bf16(v[2], v[3]); po[i] = w; } }
    rowwise_phase<0>(PIN(0), HB, nullptr, nullptr, 0.f, RS, nullptr, wg, nwg, 0, MTOK);
    xcd_barrier(xb);
    if (grp == 1) {
        { CvtDesc d{PIN(5), nullptr, (bf16_t*)(ws + OFF_W1B), DFF, DM, DM, 0, nullptr}; cvt_run(d, lds, gi, ng); }
        { CvtDesc d{PIN(8), nullptr, (bf16_t*)(ws + OFF_WQKV), DM, NQKV, NQKV, 2, PIN(7)}; cvt_run(d, lds, gi, ng); }
        { CvtDesc d{PIN(11), nullptr, (bf16_t*)(ws + OFF_WO), DM, DM, DM, 0, nullptr}; cvt_run(d, lds, gi, ng); }
        { CvtDesc d{PIN(14), PIN(15), (bf16_t*)(ws + OFF_W2A), DM, DFF, 2 * DFF, 1, PIN(13)}; cvt_run(d, lds, gi, ng); }
        { CvtDesc d{PIN(16), nullptr, (bf16_t*)(ws + OFF_W2B), DFF, DM, DM, 0, nullptr}; cvt_run(d, lds, gi, ng); }
        { CvtDesc d{PIN(19), nullptr, (bf16_t*)(ws + OFF_WPG), DM, DM, DM, 0, PIN(18)}; cvt_run(d, lds, gi, ng); }
        { CvtDesc d{PIN(20), nullptr, (bf16_t*)(ws + OFF_WPP), PLE, DM, DM, 0, nullptr}; cvt_run(d, lds, gi, ng); }
        xcd_barrier(xg);
        if (gi == 0 && threadIdx.x == 0) __hip_atomic_store(wflag, 1u, __ATOMIC_RELAXED, __HIP_MEMORY_SCOPE_AGENT);
    }
    { pg8::Gemm g{HBg, (const bf16_t*)(ws + OFF_W1A), SEQ, 2 * DFF, DM}; S.init(SEQ, 2 * DFF, ng, gi); pg8::EpiSwiglu E{Xg, RSg}; pg8::gemm_phase(lds, g, S, E); }
    if (grp == 0) {
        if (threadIdx.x == 0) { unsigned sp = 0; while (__hip_atomic_load(wflag, __ATOMIC_RELAXED, __HIP_MEMORY_SCOPE_AGENT) == 0u && ++sp < (1u << 24)) __builtin_amdgcn_s_sleep(8); }
    }
    xcd_barrier(xg);
    { pg8::Gemm g{Xg, (const bf16_t*)(ws + OFF_W1B), SEQ, DM, DFF}; S.init(SEQ, DM, ng, gi); pg8::EpiPlain E{Fg, DM}; pg8::gemm_phase(lds, g, S, E); }
    xcd_barrier(xg);
    rowwise_phase<3>(nullptr, HB, F, PIN(6), 0.5f, RS, nullptr, gi, ng, row0, row0 + SEQ);
    xcd_barrier(xg);
    { pg8::Gemm g{HBg, (const bf16_t*)(ws + OFF_WQKV), SEQ, NQKV, DM}; S.init(SEQ, NQKV, ng, gi);
      pg8::EpiQkv E{Xg, (const float*)(ws + OFF_ROPE), (const float*)(ws + OFF_ROPE) + SEQ * 64, RSg}; pg8::gemm_phase(lds, g, S, E); }
    xcd_barrier(xg);
    attn_phase(ws, (unsigned char*)POUT, PIN(9), lds, gi, ng, grp);
    xcd_barrier(xg);
    merge_phase(ws, (unsigned char*)POUT, PIN(10), gi, ng, grp);
    xcd_barrier(xg);
    { pg8::Gemm g{Xg, (const bf16_t*)(ws + OFF_WO), SEQ, DM, DM}; S.init(SEQ, DM, ng, gi); pg8::EpiPlain E{Fg, DM}; pg8::gemm_phase(lds, g, S, E); }
    xcd_barrier(xg);
    rowwise_phase<3>(nullptr, HB, F, PIN(12), 1.0f, RS, nullptr, gi, ng, row0, row0 + SEQ);
    xcd_barrier(xg);
    { pg8::Gemm g{HBg, (const bf16_t*)(ws + OFF_W2A), SEQ, 2 * DFF, DM}; S.init(SEQ, 2 * DFF, ng, gi); pg8::EpiSwiglu E{Xg, RSg}; pg8::gemm_phase(lds, g, S, E); }
    xcd_barrier(xg);
    { pg8::Gemm g{Xg, (const bf16_t*)(ws + OFF_W2B), SEQ, DM, DFF}; S.init(SEQ, DM, ng, gi); pg8::EpiPlain E{Fg, DM}; pg8::gemm_phase(lds, g, S, E); }
    xcd_barrier(xg);
    rowwise_phase<3>(nullptr, HB, F, PIN(17), 0.5f, RS, nullptr, gi, ng, row0, row0 + SEQ);
    xcd_barrier(xg);
    { pg8::Gemm g{(const bf16_t*)(ws + OFF_PBF) + (size_t)row0 * PLE, (const bf16_t*)(ws + OFF_WPP), SEQ, DM, PLE}; S.init(SEQ, DM, ng, gi); pg8::EpiPlain E{Xg, DM}; pg8::gemm_phase(lds, g, S, E); }
    asm volatile("s_waitcnt vmcnt(0)" ::: "memory"); __syncthreads();
    { pg8::Gemm g{HBg, (const bf16_t*)(ws + OFF_WPG), SEQ, DM, DM}; S.init(SEQ, DM, ng, gi); pg8::EpiPle E{Fg, Xg, RSg}; pg8::gemm_phase(lds, g, S, E); }
    xcd_barrier(xg);
    rowwise_phase<2>(nullptr, HB, F, PIN(21), 1.0f, nullptr, POUT, gi, ng, row0, row0 + SEQ);
}

extern "C" void kernel_launch(void* const* d_in, const int* in_sizes, int n_in, void* d_out, int out_size, void* d_ws, size_t ws_size, hipStream_t stream) {
    static int grid_blocks = 0;
    if (grid_blocks == 0) {
        if (n_in != 22 || ws_size < WS_END) { fprintf(stderr, "kernel_launch: unexpected n_in %d or ws_size %zu (< %zu)\n", n_in, ws_size, (size_t)WS_END); grid_blocks = -1; return; }
        int dev = 0, cus = 0, per_cu = 0;
        hipGetDevice(&dev);
        hipDeviceGetAttribute(&cus, hipDeviceAttributeMultiprocessorCount, dev);
        hipFuncSetAttribute((const void*)fwd_megakernel, hipFuncAttributeMaxDynamicSharedMemorySize, LDS_BYTES);
        hipOccupancyMaxActiveBlocksPerMultiprocessor(&per_cu, (const void*)fwd_megakernel, 512, LDS_BYTES);
        if (per_cu < 1) per_cu = 1;
        grid_blocks = cus * (per_cu > 1 ? 1 : per_cu);
        (void)hipGetLastError();
    }
    if (grid_blocks < 0) return;
    Params p{};
    for (int i = 0; i < 22; ++i) p.in[i] = (const float*)d_in[i];
    p.out = (float*)d_out; p.ws = (unsigned char*)d_ws;
    (void)hipMemsetAsync((unsigned char*)d_ws + OFF_BAR, 0, 65536, stream);
    void* args[] = {&p};
    hipError_t e = hipLaunchCooperativeKernel((const void*)fwd_megakernel, dim3(grid_blocks), dim3(512), args, LDS_BYTES, stream);
    if (e != hipSuccess) fprintf(stderr, "cooperative launch failed: %s (grid %d)\n", hipGetErrorString(e), grid_blocks);
}
```
